# Optimizing an MI355X kernel written in HIP

```python
import math
import jax, jax.numpy as jnp
from jax import lax
import numpy as np

D_MODEL = 2048
BATCH = 2
SEQ = 8192
DEPTH = 4
DEC_BATCH = 32
DEC_SEQ = 32
PAST_LEN = 1024

CHUNK = 64
EPS = 1e-6
LRU_WIDTH = D_MODEL // 2
LRU_HEADS = 16
LRU_HEAD_DIM = LRU_WIDTH // LRU_HEADS
LRU_CONV = 4
LRU_C = 8.0
SCONV_WIDTH = D_MODEL // 2
SCONV_K = 3
MEM_LEN = 256
MEM_HEADS = 4
MEM_WIDTH = D_MODEL // 2
MEM_HEAD_DIM = MEM_WIDTH // MEM_HEADS
N_BRANCH = 3
D_FF = 4 * D_MODEL
IN_SPLITS = [
    LRU_WIDTH,
    2 * LRU_WIDTH,
    2 * LRU_WIDTH + SCONV_WIDTH,
    2 * LRU_WIDTH + 2 * SCONV_WIDTH,
    2 * LRU_WIDTH + 3 * SCONV_WIDTH,
    2 * LRU_WIDTH + 3 * SCONV_WIDTH + MEM_WIDTH,
]
IN_COLS = 2 * LRU_WIDTH + 3 * SCONV_WIDTH + MEM_WIDTH + N_BRANCH * D_MODEL

kernel_name = "hawk_shortconv_memxattn_streaming_encoder_step"


def rms_norm(x, g):
    xf = x.astype(jnp.float32)
    var = jnp.mean(xf * xf, axis=-1, keepdims=True)
    return (xf * lax.rsqrt(var + EPS)).astype(x.dtype) * g


def causal_depthwise_conv(u, buf, w, b=None):
    width = w.shape[0]
    t = u.shape[1]
    up = jnp.concatenate([buf, u], axis=1)
    y = up[:, 0:t] * w[0]
    for k in range(1, width):
        y = y + up[:, k:k + t] * w[k]
    if b is not None:
        y = y + b
    return y, up[:, -(width - 1):]


def block_diag_linear(x, w, b):
    bsz, t, _ = x.shape
    xh = x.reshape(bsz, t, LRU_HEADS, LRU_HEAD_DIM)
    y = jnp.einsum('bthi,hij->bthj', xh, w).reshape(bsz, t, LRU_WIDTH)
    return y + b


def chunked_linear_scan(a, b, h0):
    bsz, t, w = a.shape
    pad = (-t) % CHUNK
    a = jnp.pad(a, ((0, 0), (0, pad), (0, 0)), constant_values=1.0)
    b = jnp.pad(b, ((0, 0), (0, pad), (0, 0)))
    n = (t + pad) // CHUNK
    a = a.reshape(bsz, n, CHUNK, w).transpose(1, 0, 2, 3)
    b = b.reshape(bsz, n, CHUNK, w).transpose(1, 0, 2, 3)

    def combine(left, right):
        a_l, b_l = left
        a_r, b_r = right
        return a_l * a_r, a_r * b_l + b_r

    def step(h, ab):
        a_c, b_c = ab
        a_cum, b_cum = lax.associative_scan(combine, (a_c, b_c), axis=1)
        hs = a_cum * h[:, None, :] + b_cum
        return hs[:, -1], hs

    h_last, hs = lax.scan(step, h0, (a, b))
    hs = hs.transpose(1, 0, 2, 3).reshape(bsz, n * CHUNK, w)[:, :t]
    return hs, h_last


def rg_lru(x, h0, w_a, b_a, w_i, b_i, lam):
    f32 = jnp.float32
    r = jax.nn.sigmoid(block_diag_linear(x, w_a, b_a).astype(f32))
    i = jax.nn.sigmoid(block_diag_linear(x, w_i, b_i).astype(f32))
    log_a = -LRU_C * r * jax.nn.softplus(-lam.astype(f32))
    a = jnp.exp(log_a)
    mult = jnp.sqrt(-jnp.expm1(2.0 * log_a))
    bx = mult * (i * x.astype(f32))
    hs, h_last = chunked_linear_scan(a, bx, h0.astype(f32))
    return hs.astype(x.dtype), h_last.astype(h0.dtype)


def memory_kv(mem, g_mem, w_mem_kv):
    bsz, m, _ = mem.shape
    kv = rms_norm(mem, g_mem) @ w_mem_kv
    k, v = jnp.split(kv, 2, axis=-1)
    return (k.reshape(bsz, m, MEM_HEADS, MEM_HEAD_DIM),
            v.reshape(bsz, m, MEM_HEADS, MEM_HEAD_DIM))


def memory_attention(q, k, v):
    bsz, t, _ = q.shape
    qh = q.reshape(bsz, t, MEM_HEADS, MEM_HEAD_DIM)
    s = jnp.einsum('bthd,bmhd->bhtm', qh, k).astype(jnp.float32) * (MEM_HEAD_DIM ** -0.5)
    p = jax.nn.softmax(s, axis=-1).astype(v.dtype)
    o = jnp.einsum('bhtm,bmhd->bthd', p, v)
    return o.reshape(bsz, t, MEM_WIDTH)


def run_layer(x, mem_k, mem_v, h0, lru_buf, sconv_buf, lw):
    bsz, t, _ = x.shape
    xn = rms_norm(x, lw['g_mix_pre'])
    proj = xn @ lw['w_in']
    lru_x, lru_gate, sc_b, sc_c, sc_h, q, gate_logits = jnp.split(proj, IN_SPLITS, axis=-1)
    u, lru_buf_new = causal_depthwise_conv(lru_x, lru_buf, lw['lru_conv_w'], lw['lru_conv_b'])
    h, h_last = rg_lru(u, h0, lw['lru_w_a'], lw['lru_b_a'], lw['lru_w_i'], lw['lru_b_i'], lw['lru_lambda'])
    y_lru = (h * jax.nn.gelu(lru_gate)) @ lw['w_branch_lru']
    cv, sconv_buf_new = causal_depthwise_conv(sc_c * sc_h, sconv_buf, lw['sconv_w'])
    y_conv = (sc_b * cv) @ lw['w_branch_conv']
    y_mem = memory_attention(q, mem_k, mem_v) @ lw['w_branch_mem']
    gates = jax.nn.sigmoid((gate_logits + lw['b_gate'].reshape(-1)).astype(jnp.float32)).astype(x.dtype)
    gates = gates.reshape(bsz, t, N_BRANCH, D_MODEL)
    merged = gates[:, :, 0] * y_lru + gates[:, :, 1] * y_conv + gates[:, :, 2] * y_mem
    x = x + rms_norm(merged @ lw['w_out'], lw['g_mix_post'])
    hid = jnp.square(jax.nn.relu(rms_norm(x, lw['g_mlp_pre']) @ lw['w_up']))
    x = x + rms_norm(hid @ lw['w_down'], lw['g_mlp_post'])
    return x, h_last, lru_buf_new, sconv_buf_new


def setup_inputs(seed: int = 0) -> dict:
    key = jax.random.key(seed)
    ks = jax.random.split(key, 32)
    f32 = jnp.float32

    def nrm(k, shape, scale):
        return jax.random.normal(k, shape, f32) * scale

    u = jax.random.uniform(ks[0], (DEPTH, LRU_WIDTH), f32, 0.9, 0.999)
    s = u ** (1.0 / LRU_C)
    lru_lambda = jnp.log(s) - jnp.log1p(-s)
    return {
        "x_prompt": nrm(ks[1], (BATCH, SEQ, D_MODEL), 1.0),
        "x_sample": nrm(ks[2], (DEC_BATCH, DEC_SEQ, D_MODEL), 1.0),
        "mem_prompt": nrm(ks[3], (BATCH, MEM_LEN, D_MODEL), 1.0),
        "state_lru_h": nrm(ks[4], (DEPTH, DEC_BATCH, LRU_WIDTH), 0.5),
        "state_lru_conv": nrm(ks[5], (DEPTH, DEC_BATCH, LRU_CONV - 1, LRU_WIDTH), 1.0),
        "state_sconv": nrm(ks[6], (DEPTH, DEC_BATCH, SCONV_K - 1, SCONV_WIDTH), 1.0),
        "cache_mem_k": nrm(ks[7], (DEPTH, DEC_BATCH, MEM_LEN, MEM_HEADS, MEM_HEAD_DIM), 1.0),
        "cache_mem_v": nrm(ks[8], (DEPTH, DEC_BATCH, MEM_LEN, MEM_HEADS, MEM_HEAD_DIM), 1.0),
        "g_mix_pre": 1.0 + nrm(ks[9], (DEPTH, D_MODEL), 0.02),
        "w_in": nrm(ks[10], (DEPTH, D_MODEL, IN_COLS), D_MODEL ** -0.5),
        "b_gate": nrm(ks[11], (DEPTH, N_BRANCH, D_MODEL), 0.01),
        "lru_conv_w": nrm(ks[12], (DEPTH, LRU_CONV, LRU_WIDTH), LRU_CONV ** -0.5),
        "lru_conv_b": nrm(ks[13], (DEPTH, LRU_WIDTH), 0.01),
        "lru_w_a": nrm(ks[14], (DEPTH, LRU_HEADS, LRU_HEAD_DIM, LRU_HEAD_DIM), LRU_HEAD_DIM ** -0.5),
        "lru_b_a": nrm(ks[15], (DEPTH, LRU_WIDTH), 0.01),
        "lru_w_i": nrm(ks[16], (DEPTH, LRU_HEADS, LRU_HEAD_DIM, LRU_HEAD_DIM), LRU_HEAD_DIM ** -0.5),
        "lru_b_i": nrm(ks[17], (DEPTH, LRU_WIDTH), 0.01),
        "lru_lambda": lru_lambda,
        "w_branch_lru": nrm(ks[18], (DEPTH, LRU_WIDTH, D_MODEL), LRU_WIDTH ** -0.5),
        "sconv_w": nrm(ks[19], (DEPTH, SCONV_K, SCONV_WIDTH), SCONV_K ** -0.5),
        "w_branch_conv": nrm(ks[20], (DEPTH, SCONV_WIDTH, D_MODEL), SCONV_WIDTH ** -0.5),
        "g_mem": 1.0 + nrm(ks[21], (DEPTH, D_MODEL), 0.02),
        "w_mem_kv": nrm(ks[22], (DEPTH, D_MODEL, 2 * MEM_WIDTH), D_MODEL ** -0.5),
        "w_branch_mem": nrm(ks[23], (DEPTH, MEM_WIDTH, D_MODEL), MEM_WIDTH ** -0.5),
        "w_out": nrm(ks[24], (DEPTH, D_MODEL, D_MODEL), D_MODEL ** -0.5),
        "g_mix_post": 1.0 + nrm(ks[25], (DEPTH, D_MODEL), 0.02),
        "g_mlp_pre": 1.0 + nrm(ks[26], (DEPTH, D_MODEL), 0.02),
        "w_up": nrm(ks[27], (DEPTH, D_MODEL, D_FF), D_MODEL ** -0.5),
        "w_down": nrm(ks[28], (DEPTH, D_FF, D_MODEL), D_FF ** -0.5),
        "g_mlp_post": 1.0 + nrm(ks[29], (DEPTH, D_MODEL), 0.02),
    }


def reference(x_prompt, x_sample, mem_prompt, state_lru_h, state_lru_conv, state_sconv,
              cache_mem_k, cache_mem_v, g_mix_pre, w_in, b_gate, lru_conv_w, lru_conv_b,
              lru_w_a, lru_b_a, lru_w_i, lru_b_i, lru_lambda, w_branch_lru, sconv_w,
              w_branch_conv, g_mem, w_mem_kv, w_branch_mem, w_out, g_mix_post, g_mlp_pre,
              w_up, w_down, g_mlp_post):
    dt = x_prompt.dtype
    hp = x_prompt
    p_h0 = jnp.zeros((BATCH, LRU_WIDTH), dt)
    p_lb0 = jnp.zeros((BATCH, LRU_CONV - 1, LRU_WIDTH), dt)
    p_sb0 = jnp.zeros((BATCH, SCONV_K - 1, SCONV_WIDTH), dt)
    hs = x_sample
    p_h, p_lb, p_sb, p_mk, p_mv = [], [], [], [], []
    s_h, s_lb, s_sb = [], [], []
    for l in range(DEPTH):
        lw = dict(g_mix_pre=g_mix_pre[l], w_in=w_in[l], b_gate=b_gate[l],
                  lru_conv_w=lru_conv_w[l], lru_conv_b=lru_conv_b[l],
                  lru_w_a=lru_w_a[l], lru_b_a=lru_b_a[l], lru_w_i=lru_w_i[l], lru_b_i=lru_b_i[l],
                  lru_lambda=lru_lambda[l], w_branch_lru=w_branch_lru[l], sconv_w=sconv_w[l],
                  w_branch_conv=w_branch_conv[l], w_branch_mem=w_branch_mem[l], w_out=w_out[l],
                  g_mix_post=g_mix_post[l], g_mlp_pre=g_mlp_pre[l], w_up=w_up[l],
                  w_down=w_down[l], g_mlp_post=g_mlp_post[l])
        mk, mv = memory_kv(mem_prompt, g_mem[l], w_mem_kv[l])
        hp, h_last, lb_new, sb_new = run_layer(hp, mk, mv, p_h0, p_lb0, p_sb0, lw)
        p_h.append(h_last); p_lb.append(lb_new); p_sb.append(sb_new)
        p_mk.append(mk); p_mv.append(mv)
        hs, h_last, lb_new, sb_new = run_layer(hs, cache_mem_k[l], cache_mem_v[l], state_lru_h[l],
                                               state_lru_conv[l], state_sconv[l], lw)
        s_h.append(h_last); s_lb.append(lb_new); s_sb.append(sb_new)
    return (hp, hs,
            jnp.stack(p_h), jnp.stack(p_lb), jnp.stack(p_sb), jnp.stack(p_mk), jnp.stack(p_mv),
            jnp.stack(s_h), jnp.stack(s_lb), jnp.stack(s_sb))
```

```cpp
#include <hip/hip_runtime.h>
#include <cstdio>
#include <cstdint>

#define LAS __attribute__((address_space(3)))
#define GAS __attribute__((address_space(1)))
typedef unsigned short bf16_t;
typedef short bf16x8 __attribute__((ext_vector_type(8)));
typedef short s16x4 __attribute__((ext_vector_type(4)));
typedef float f32x4 __attribute__((ext_vector_type(4)));
typedef float f32x2 __attribute__((ext_vector_type(2)));
typedef float f32x16 __attribute__((ext_vector_type(16)));
typedef unsigned u32x4 __attribute__((ext_vector_type(4)));
typedef unsigned u32x2 __attribute__((ext_vector_type(2)));
typedef __bf16 bf16x2_t __attribute__((ext_vector_type(2)));

#ifndef DUP_THIN
#define DUP_THIN 1
#endif
#ifndef DUP_LRU
#define DUP_LRU 1
#endif
#ifndef DUP_ATT
#define DUP_ATT 1
#endif
#ifndef DUP_SC
#define DUP_SC 1
#endif
#ifndef DUP_NORM
#define DUP_NORM 1
#endif
#ifndef DUP_BAR
#define DUP_BAR 1
#endif
#ifndef DUP_PRO
#define DUP_PRO 1
#endif
#ifndef DUP_GIN
#define DUP_GIN 1
#endif
#ifndef DUP_GDN
#define DUP_GDN 1
#endif
#ifndef DUP_GUP
#define DUP_GUP 1
#endif
#ifndef DUP_GBR
#define DUP_GBR 1
#endif
#ifndef DUP_GOUT
#define DUP_GOUT 1
#endif
#ifndef PG8_SP2
#define PG8_SP2 1
#endif
#ifndef PG8_ALIGN
#define PG8_ALIGN 1
#endif
#ifndef MK_MULTI
#define MK_MULTI 0
#endif

constexpr int DM = 2048, NBATCH = 2, SEQ = 8192, DEPTH = 4, DBATCH = 32, DSEQ = 32;
constexpr int MP = NBATCH * SEQ, MS = DBATCH * DSEQ, MT = MP + MS;
constexpr int LW = 1024, LHEADS = 16, LHD = 64;
constexpr int MEMLEN = 256, MHEADS = 4, MHD = 256, MW = 1024;
constexpr int INC = 12288, DFF = 8192;
constexpr int NPANEL = MT / 256;
constexpr float EPS = 1e-6f;
constexpr float LOG2E = 1.4426950408889634f;
constexpr int C_LX = 0, C_LG = 1024, C_SB = 2048, C_SC = 3072, C_SH = 4096, C_Q = 5120, C_GT = 6144;
constexpr int C_I8 = 5120, NI8 = 12288 - C_I8;

constexpr size_t O_YP = 0, O_YS = (size_t)MP * DM, O_PLH = O_YS + (size_t)MS * DM, O_PLC = O_PLH + DEPTH * NBATCH * LW,
                 O_PSC = O_PLC + DEPTH * NBATCH * 3 * LW, O_PMK = O_PSC + DEPTH * NBATCH * 2 * LW, O_PMV = O_PMK + (size_t)DEPTH * NBATCH * MEMLEN * MW,
                 O_SLH = O_PMV + (size_t)DEPTH * NBATCH * MEMLEN * MW, O_SLC = O_SLH + DEPTH * DBATCH * LW, O_SSC = O_SLC + DEPTH * DBATCH * 3 * LW,
                 O_END = O_SSC + DEPTH * DBATCH * 2 * LW;
static_assert(O_END == 40681472, "output size");

constexpr size_t MiB = 1u << 20;
constexpr size_t WS_CTL = 1 * MiB, CTL_ZERO_BYTES = 1 * MiB;
constexpr size_t WS_SSX = 2 * MiB;
constexpr size_t WS_SSY = WS_SSX + 128 * 1024;
constexpr size_t WS_MRSTD = WS_SSY + (size_t)MT * 32 * 4;
constexpr size_t WS_PA = 5 * MiB, WS_PB = WS_PA + 256 * 1024;
constexpr size_t WS_SLCB = WS_PB + 256 * 1024;
constexpr size_t WS_WAT = WS_SLCB + 768 * 1024, WS_WIT = WS_WAT + 512 * 1024;
constexpr size_t WS_MEMB = WS_WIT + 512 * 1024;
static_assert(WS_MEMB + 2 * MiB <= 10 * MiB, "small buffers below the weights");
constexpr size_t WS_GRAN = 0;
constexpr size_t WS_WIN = 10 * MiB;
constexpr size_t SZ_WIN = (size_t)INC * DM * 2;
constexpr size_t WS_WBR = WS_WIN + 4 * SZ_WIN;
constexpr size_t SZ_WBR1 = (size_t)DM * 1024 * 2;
constexpr size_t WS_WOUT = WS_WBR + 12 * SZ_WBR1;
constexpr size_t SZ_WOUT = (size_t)DM * DM * 2;
constexpr size_t WS_WUP = WS_WOUT + 4 * SZ_WOUT;
constexpr size_t SZ_WUP = (size_t)DFF * DM * 2;
constexpr size_t WS_WDN = WS_WUP + 4 * SZ_WUP;
constexpr size_t WS_WKV = WS_WDN + 4 * SZ_WUP;
constexpr size_t WS_XB = WS_WKV + 4 * SZ_WOUT;
constexpr size_t SZ_ACT2K = (size_t)MT * DM * 2;
constexpr size_t WS_PROJ = WS_XB + SZ_ACT2K;
constexpr size_t WS_ABR = WS_PROJ + (size_t)MT * INC * 2;
constexpr size_t SZ_ABR1 = (size_t)MT * 1024 * 2;
constexpr size_t WS_MERGED = WS_ABR + 3 * SZ_ABR1;
constexpr size_t WS_Y = WS_MERGED + SZ_ACT2K;
constexpr size_t WS_KP = WS_Y + SZ_ACT2K;
constexpr size_t WS_VTP = WS_KP + 4 * MiB;
constexpr size_t WS_KS = WS_VTP + 4 * MiB;
constexpr size_t WS_VTS = WS_KS + 64 * MiB;
constexpr size_t WS_G8 = WS_KS;
static_assert((size_t)MT * 3 * DM <= 128 * MiB, "gate bytes fit the old cache-copy area");
constexpr size_t WS_BP = WS_VTS + 64 * MiB;
constexpr size_t WS_XQ = WS_BP + 24 * MiB;
constexpr size_t WS_END = WS_XQ + (size_t)MT * DM;
constexpr size_t WS_SA = WS_MRSTD + 4096;
constexpr size_t WQ_OFF = (size_t)C_I8 * DM * 2;
constexpr int CW_CMAX = 16384, CM_L = NI8 + DFF + DM;
constexpr int CW_RCNT = 8192, CW_CSUM = 98304, CW_RMAX = 131072;
static_assert(CW_CMAX + DEPTH * CM_L <= CW_CSUM && CW_CSUM + DEPTH * DM <= CW_RMAX && (CW_RMAX + DEPTH * MT) * 4 <= (int)CTL_ZERO_BYTES, "control words inside the memset region");
__host__ __device__ constexpr int cw_csum9(int l) { return l < 3 ? CW_RMAX + DEPTH * MT + l * 9 * DM : CW_CSUM + DEPTH * DM; }
static_assert((CW_RMAX + DEPTH * MT + 3 * 9 * DM) * 4 <= (int)CTL_ZERO_BYTES && CW_CSUM + DEPTH * DM + 9 * DM <= CW_RMAX, "slice sums inside the memset region");
static_assert((CW_CMAX + DEPTH * CM_L) * 4 <= (int)CTL_ZERO_BYTES, "column maxima inside the memset region");
static_assert(WS_SA + (size_t)MT * 4 <= WS_PA && WS_END <= (size_t)1536 * MiB, "d_ws map");

constexpr int RING_BYTES = 131072;
constexpr int MISC_OFF = RING_BYTES;
constexpr int LDS_BYTES = 147456;

__device__ __forceinline__ unsigned cvtpk(float lo, float hi) { f32x2 v = {lo, hi}; bf16x2_t b = __builtin_convertvector(v, bf16x2_t); return __builtin_bit_cast(unsigned, b); }
__device__ __forceinline__ u32x4 pack8(f32x4 a, f32x4 b) { u32x4 w; w.x = cvtpk(a[0], a[1]); w.y = cvtpk(a[2], a[3]); w.z = cvtpk(b[0], b[1]); w.w = cvtpk(b[2], b[3]); return w; }
__device__ __forceinline__ float bf_lo(unsigned w) { return __uint_as_float(w << 16); }
__device__ __forceinline__ float bf_hi(unsigned w) { return __uint_as_float(w & 0xffff0000u); }
__device__ __forceinline__ float bf1(bf16_t v) { return __uint_as_float(((unsigned)v) << 16); }
__device__ __forceinline__ void unpack8(u32x4 w, f32x4& a, f32x4& b) { a = (f32x4){bf_lo(w.x), bf_hi(w.x), bf_lo(w.y), bf_hi(w.y)}; b = (f32x4){bf_lo(w.z), bf_hi(w.z), bf_lo(w.w), bf_hi(w.w)}; }
__device__ __forceinline__ bf16_t f2bf(float f) { return (bf16_t)(cvtpk(f, 0.f) & 0xffffu); }
__device__ __forceinline__ float fsigmoid(float v) { return __builtin_amdgcn_rcpf(1.0f + __builtin_amdgcn_exp2f(-LOG2E * v)); }
__device__ __forceinline__ float fgelu_tanh(float v) { const float t = v + 0.044715f * v * v * v; return v * __builtin_amdgcn_rcpf(1.0f + __builtin_amdgcn_exp2f(-2.3022081985f * t)); }
__device__ __forceinline__ float wave_sum(float v) {
#pragma unroll
    for (int o = 1; o < 64; o <<= 1) v += __shfl_xor(v, o);
    return v;
}
#define LDS_WAIT() asm volatile("s_waitcnt lgkmcnt(0)" ::: "memory")
#define VM_WAIT() asm volatile("s_waitcnt vmcnt(0)" ::: "memory")

namespace pg8 {
constexpr int BM = 256, BK = 64, HALF = 128, HTB = HALF * BK * 2, STAGE_BYTES = 8 * HTB, NXCD = 8, WGM = 8;
__host__ __device__ __forceinline__ int lds_byte(int r, int c) { const int st = (r >> 4) * 2 + (c >> 5), rr = r & 15, cc = c & 31, ob = rr * 64 + cc * 2; return st * 1024 + (ob ^ (((ob >> 9) & 1) << 5)); }
__host__ __device__ __forceinline__ void stage_rc(int b, int& R, int& C) { const int st = b / 1024, sb = b % 1024, swz = sb ^ (((sb >> 9) & 1) << 5); R = (st >> 1) * 16 + swz / 64; C = (st & 1) * 32 + (swz % 64) / 2; }
__host__ __device__ __forceinline__ int perm32(int rho) { const int n = rho >> 4, i = rho & 15; return 8 * (i >> 2) + 4 * n + (i & 3); }

struct Unit { int pm, pn, seg, ks, nt, koff; };
struct Gemm { const char* A; const char* Bt; int lda, ldb, K; size_t segA, segB; };

struct StaticOrder {
    int nM, nN, nwg, G, c, wgm;
    __device__ __forceinline__ void init(int M, int N, int G_, int c_) { nM = M / BM; nN = N / BM; nwg = nM * nN; G = G_; c = c_; wgm = nN <= 8 ? 4 : WGM; }
    __device__ __forceinline__ bool unit(int i, Unit& u) const {
        const long L = (long)i * G + c; const bool ok = L < nwg;
        int wgid = ok ? (int)L : 0; { const int q = nwg / NXCD, r = nwg % NXCD, xcd = wgid % NXCD, off = wgid / NXCD; wgid = (xcd < r ? xcd * (q + 1) : r * (q + 1) + (xcd - r) * q) + off; }
        const int nig = wgm * nN, gid = wgid / nig, fm = gid * wgm, gsz = (nM - fm) < wgm ? (nM - fm) : wgm;
        u.pm = fm + ((wgid % nig) % gsz); u.pn = (wgid % nig) / gsz; return ok;
    }
    int ntk;
    __device__ __forceinline__ bool next(int i, Unit& u) const { u.seg = 0; u.ks = -1; u.nt = ntk; u.koff = 0; return unit(i, u); }
};
struct SplitOrder : StaticOrder {
    __device__ __forceinline__ bool next(int i, Unit& u) const {
        Unit a; const bool oka = unit(i < 2 ? i : 0, a);
        const bool sp = i >= 2; const int tile = c >> 3;
        u.seg = 0; u.pm = sp ? 64 + (tile >> 3) : a.pm; u.pn = sp ? (tile & 7) : a.pn; u.ks = sp ? (c & 7) : -1; u.nt = sp ? (ntk >> 3) : ntk; u.koff = sp ? (c & 7) * (ntk >> 3) * (BK * 2) : 0;
        return sp ? (i == 2 && c < 256) : oka;
    }
};
struct Seg3Order : StaticOrder {
    __device__ __forceinline__ bool next(int i, Unit& u) const { const int t = i / 3; u.seg = i - 3 * t; u.ks = -1; u.nt = ntk; u.koff = 0; return unit(t, u); }
};
struct SegSubOrder {
    int c;
    __device__ __forceinline__ bool next(int i, Unit& u) const {
        const int tile = c / 3, sg = c - 3 * tile;
        u.pm = 64 + (tile >> 3); u.pn = tile & 7; u.seg = sg; u.ks = sg; u.nt = 1024 / BK; u.koff = 0;
        return i == 0 && c < 96;
    }
};
struct UpOrder {
    int c, G, ntk;
    __device__ __forceinline__ bool next(int i, Unit& u) const {
        const int x = c & 7, j = c >> 3; const bool last = i >= 8, lin = G != 256; const int L = i * G + c;
        const int pm = last ? 64 + (x >> 1) : 8 * i + 4 * (x >> 2) + (j & 3), pn = last ? 16 * (x & 1) + (j & 15) : 8 * (x & 3) + (j >> 2);
        u.pm = lin ? (L >> 5) : pm; u.pn = lin ? (L & 31) : pn; u.seg = 0; u.ks = -1; u.nt = ntk; u.koff = 0;
        return lin ? (L < (MT / BM) * (DFF / BM)) : (last ? (i == 8 && j < 16) : true);
    }
};
struct KvOrder {
    int c;
    __device__ __forceinline__ bool next(int i, Unit& u) const { if (i > 0 || c < 80 || c >= 144) return false; const int k = c - 80; u.pm = k & 1; u.pn = k >> 1; u.seg = 0; u.ks = -1; u.nt = DM / BK; u.koff = 0; return true; }
};

typedef int v4i_t __attribute__((ext_vector_type(4)));
template <bool I8> __device__ __forceinline__ f32x4 mma16(bf16x8 b, bf16x8 a, f32x4 c) {
    if constexpr (I8) return __builtin_bit_cast(f32x4, __builtin_amdgcn_mfma_i32_16x16x64_i8(__builtin_bit_cast(v4i_t, b), __builtin_bit_cast(v4i_t, a), __builtin_bit_cast(v4i_t, c), 0, 0, 0));
    else return __builtin_amdgcn_mfma_f32_16x16x32_bf16(b, a, c, 0, 0, 0);
}
template <class T, class = void> struct epi_wide { static constexpr bool value = false; };
template <class T> struct epi_wide<T, decltype((void)T::WIDE)> { static constexpr bool value = true; };
template <class Epi, class Sched, bool I8 = false>
__device__ __forceinline__ void gemm_phase(LAS unsigned char* lds, const Gemm g, const Sched& S, const Epi& E) {
    int tid = threadIdx.x; asm volatile("" : "+v"(tid));
    const int wid = __builtin_amdgcn_readfirstlane(tid >> 6), lane = tid & 63, wr = wid >> 2, wc = wid & 3, fr = lane & 15, fq = lane >> 4;
    unsigned voffA[2], voffB[2];
#pragma unroll
    for (int i = 0; i < 2; ++i) { int R, C; stage_rc(tid * 16 + i * 8192, R, C); const int Rb = Epi::PERM ? ((R >> 5) * 64 + perm32(R & 31)) : R;
        voffA[i] = (unsigned)(R * g.lda + C) * 2u; voffB[i] = (unsigned)(Rb * g.ldb + C) * 2u; }
    const size_t kstep = (size_t)(BK * 2);
    const size_t hstepA = (size_t)HALF * g.lda * 2, hstepB = (size_t)(Epi::PERM ? 32 : HALF) * g.ldb * 2;
    const size_t tstepA = 2 * hstepA, tstepB = (size_t)BM * g.ldb * 2;
    const unsigned ldsw = (unsigned)wid * 1024u;
    const int aoff = lds_byte(wr * 64 + fr, fq * 8), boff = lds_byte(wc * 32 + fr, fq * 8);
#define PG8_SA(b, h) (((b) * 2 + (h)) * HTB)
#define PG8_SB(b, h) ((4 + (b) * 2 + (h)) * HTB)
#define PG8_STAGE(bufoff, gbase, voff) do { _Pragma("unroll") for (int _i = 0; _i < 2; ++_i) \
        __builtin_amdgcn_global_load_lds((const unsigned*)((const char*)(gbase) + (voff)[_i]), (LAS unsigned*)(lds + (bufoff) + ldsw + _i * 8192), 16, 0, 0); } while (0)
#define PG8_LDA(dst, b, h) do { _Pragma("unroll") for (int m = 0; m < 4; ++m) _Pragma("unroll") for (int k = 0; k < 2; ++k) dst[m][k] = *(const LAS bf16x8*)(lds + PG8_SA(b, h) + aoff + m * 2048 + k * 1024); } while (0)
#define PG8_LDB(dst, b, h) do { _Pragma("unroll") for (int n = 0; n < 2; ++n) _Pragma("unroll") for (int k = 0; k < 2; ++k) dst[n][k] = *(const LAS bf16x8*)(lds + PG8_SB(b, h) + boff + n * 2048 + k * 1024); } while (0)
#define PG8_MMA(ai, bj, At, Bt) do { __builtin_amdgcn_s_setprio(1); _Pragma("unroll") for (int m = 0; m < 4; ++m) _Pragma("unroll") for (int n = 0; n < 2; ++n) _Pragma("unroll") for (int k = 0; k < 2; ++k) \
        acc[ai][bj][m][n] = mma16<I8>(Bt[n][k], At[m][k], acc[ai][bj][m][n]); __builtin_amdgcn_s_setprio(0); } while (0)
#define PG8_WAIT_V(n) asm volatile("s_waitcnt vmcnt(" #n ")" ::: "memory")
#define PG8_WAIT_L(n) asm volatile("s_waitcnt lgkmcnt(" #n ")" ::: "memory")
#define PG8_BAR __builtin_amdgcn_s_barrier()
#define PG8_SCHED __builtin_amdgcn_sched_barrier(0)
    Unit cur, nxt; int ui = 0;
    if (!S.next(0, cur)) return;
    f32x4 acc[2][2][4][2];
#pragma unroll
    for (int a = 0; a < 2; ++a)
#pragma unroll
        for (int b = 0; b < 2; ++b)
#pragma unroll
            for (int m = 0; m < 4; ++m)
#pragma unroll
                for (int n = 0; n < 2; ++n) acc[a][b][m][n] = (f32x4){0.f, 0.f, 0.f, 0.f};
    bf16x8 At[4][2], B0[2][2], B1[2][2];
    const char* cA = g.A + (size_t)cur.seg * g.segA + (size_t)cur.pm * tstepA + cur.koff; const char* cB = g.Bt + (size_t)cur.seg * g.segB + (size_t)cur.pn * tstepB + cur.koff;
    if (PG8_SP2) {
    PG8_STAGE(PG8_SB(0, 0), cB, voffB); PG8_STAGE(PG8_SB(0, 1), cB + hstepB, voffB); PG8_STAGE(PG8_SA(0, 0), cA, voffA); PG8_STAGE(PG8_SA(0, 1), cA + hstepA, voffA);
    if (wr == 1) PG8_BAR;
    PG8_WAIT_V(2); PG8_BAR;
    PG8_STAGE(PG8_SB(1, 0), cB + kstep, voffB); PG8_STAGE(PG8_SA(1, 0), cA + kstep, voffA); PG8_STAGE(PG8_SB(1, 1), cB + hstepB + kstep, voffB);
    PG8_WAIT_V(6); PG8_BAR;
    } else {
    PG8_STAGE(PG8_SB(0, 0), cB, voffB); PG8_STAGE(PG8_SA(0, 0), cA, voffA); PG8_STAGE(PG8_SB(0, 1), cB + hstepB, voffB); PG8_STAGE(PG8_SA(0, 1), cA + hstepA, voffA);
    if (wr == 1) PG8_BAR;
    PG8_WAIT_V(4); PG8_BAR;
    PG8_STAGE(PG8_SB(1, 0), cB + kstep, voffB); PG8_STAGE(PG8_SA(1, 0), cA + kstep, voffA); PG8_STAGE(PG8_SB(1, 1), cB + hstepB + kstep, voffB);
    PG8_WAIT_V(6); PG8_BAR;
    }
    for (;;) {
        const bool has_next = S.next(ui + 1, nxt);
        const char* nA = has_next ? g.A + (size_t)nxt.seg * g.segA + (size_t)nxt.pm * tstepA + nxt.koff : cA; const char* nB = has_next ? g.Bt + (size_t)nxt.seg * g.segB + (size_t)nxt.pn * tstepB + nxt.koff : cB;
        const int nt = cur.nt;
        for (int t = 0; t < nt; t += 2) {
            const bool last = (t == nt - 2);
            const char* a1 = cA + (size_t)(t + 1) * kstep;
            const char* a2 = last ? nA : cA + (size_t)(t + 2) * kstep; const char* b2 = last ? nB : cB + (size_t)(t + 2) * kstep;
            const char* a3 = a2 + kstep; const char* b3 = b2 + kstep;
            if (PG8_SP2) {
            PG8_LDB(B0, 0, 0); PG8_LDB(B1, 0, 1); PG8_SCHED; PG8_LDA(At, 0, 0); PG8_STAGE(PG8_SA(1, 1), a1 + hstepA, voffA);
            PG8_WAIT_V(8); PG8_WAIT_L(0); PG8_BAR; PG8_MMA(0, 0, At, B0); PG8_MMA(0, 1, At, B1); PG8_BAR; PG8_SCHED;
            PG8_LDA(At, 0, 1); PG8_STAGE(PG8_SB(0, 0), b2, voffB); PG8_STAGE(PG8_SB(0, 1), b2 + hstepB, voffB); PG8_STAGE(PG8_SA(0, 0), a2, voffA);
            PG8_WAIT_V(8); PG8_WAIT_L(0); PG8_BAR; PG8_MMA(1, 0, At, B0); PG8_MMA(1, 1, At, B1); PG8_BAR; PG8_SCHED;
            PG8_LDB(B0, 1, 0); PG8_LDB(B1, 1, 1); PG8_SCHED; PG8_LDA(At, 1, 0); PG8_STAGE(PG8_SA(0, 1), a2 + hstepA, voffA);
            PG8_WAIT_V(8); PG8_WAIT_L(0); PG8_BAR; PG8_MMA(0, 0, At, B0); PG8_MMA(0, 1, At, B1); PG8_BAR; PG8_SCHED;
            PG8_LDA(At, 1, 1); PG8_STAGE(PG8_SB(1, 0), b3, voffB); PG8_STAGE(PG8_SB(1, 1), b3 + hstepB, voffB); PG8_STAGE(PG8_SA(1, 0), a3, voffA);
            PG8_WAIT_V(8); PG8_WAIT_L(0); PG8_BAR; PG8_MMA(1, 0, At, B0); PG8_MMA(1, 1, At, B1); PG8_BAR; PG8_SCHED;
            } else {
            PG8_LDB(B0, 0, 0); PG8_SCHED; PG8_LDA(At, 0, 0); PG8_STAGE(PG8_SA(1, 1), a1 + hstepA, voffA);
            PG8_WAIT_L(8); PG8_BAR; PG8_WAIT_L(0); PG8_MMA(0, 0, At, B0); PG8_BAR; PG8_SCHED;
            PG8_LDB(B1, 0, 1); PG8_STAGE(PG8_SB(0, 0), b2, voffB);
            PG8_BAR; PG8_WAIT_L(0); PG8_MMA(0, 1, At, B1); PG8_BAR;
            PG8_LDA(At, 0, 1); PG8_STAGE(PG8_SA(0, 0), a2, voffA);
            PG8_BAR; PG8_WAIT_L(0); PG8_MMA(1, 0, At, B0); PG8_BAR; PG8_SCHED;
            PG8_STAGE(PG8_SB(0, 1), b2 + hstepB, voffB);
            PG8_WAIT_V(6); PG8_BAR; PG8_MMA(1, 1, At, B1); PG8_BAR;
            PG8_LDB(B0, 1, 0); PG8_SCHED; PG8_LDA(At, 1, 0); PG8_STAGE(PG8_SA(0, 1), a2 + hstepA, voffA);
            PG8_WAIT_L(8); PG8_BAR; PG8_WAIT_L(0); PG8_MMA(0, 0, At, B0); PG8_BAR; PG8_SCHED;
            PG8_LDB(B1, 1, 1); PG8_STAGE(PG8_SB(1, 0), b3, voffB);
            PG8_BAR; PG8_WAIT_L(0); PG8_MMA(0, 1, At, B1); PG8_BAR;
            PG8_LDA(At, 1, 1); PG8_STAGE(PG8_SA(1, 0), a3, voffA);
            PG8_BAR; PG8_WAIT_L(0); PG8_MMA(1, 0, At, B0); PG8_BAR; PG8_SCHED;
            PG8_STAGE(PG8_SB(1, 1), b3 + hstepB, voffB);
            PG8_WAIT_V(6); PG8_BAR; PG8_MMA(1, 1, At, B1); PG8_BAR;
            }
        }
        if (PG8_ALIGN) { if (wr == 0) PG8_BAR; }
        { Unit eu = cur; eu.pm = __builtin_amdgcn_readfirstlane(eu.pm); eu.pn = __builtin_amdgcn_readfirstlane(eu.pn); eu.seg = __builtin_amdgcn_readfirstlane(eu.seg); eu.ks = __builtin_amdgcn_readfirstlane(eu.ks); asm volatile("" : "+s"(eu.pm), "+s"(eu.pn), "+s"(eu.seg), "+s"(eu.ks));
          if constexpr (epi_wide<Epi>::value) E(acc, eu, wr, wc, fr, fq, wid, lds); else E(acc, eu, wr, wc, fr, fq); }
        if (!has_next) break;
        if (nxt.seg == 0 || nxt.ks >= 0) {
#pragma unroll
            for (int a = 0; a < 2; ++a)
#pragma unroll
                for (int b = 0; b < 2; ++b)
#pragma unroll
                    for (int m = 0; m < 4; ++m)
#pragma unroll
                        for (int n = 0; n < 2; ++n) acc[a][b][m][n] = (f32x4){0.f, 0.f, 0.f, 0.f};
        }
        cur = nxt; cA = nA; cB = nB; ++ui;
        if (PG8_ALIGN) { if (wr == 1) PG8_BAR; }
    }
    PG8_WAIT_V(0);
    if (!PG8_ALIGN) { if (wr == 0) PG8_BAR; }
    PG8_BAR;
#undef PG8_SA
#undef PG8_SB
#undef PG8_STAGE
#undef PG8_LDA
#undef PG8_LDB
#undef PG8_MMA
#undef PG8_WAIT_V
#undef PG8_WAIT_L
#undef PG8_BAR
#undef PG8_SCHED
}

constexpr int CBJ = 32;
__device__ __forceinline__ unsigned dpp_ror8(unsigned v) { return (unsigned)__builtin_amdgcn_update_dpp(0, (int)v, 0x128, 0xF, 0xF, false); }
__device__ __forceinline__ void store_pair(bf16_t* grp  , size_t ld, int fr, int fq, u32x4 P0, u32x4 P1) {
    const bool up = (fr & 8) != 0;
    u32x4 snd, rcv;
    snd.x = up ? P0.x : P1.x; snd.y = up ? P0.y : P1.y; snd.z = up ? P0.z : P1.z; snd.w = up ? P0.w : P1.w;
    rcv.x = dpp_ror8(snd.x); rcv.y = dpp_ror8(snd.y); rcv.z = dpp_ror8(snd.z); rcv.w = dpp_ror8(snd.w);
    u32x4 dA, dB;
    dA.x = up ? rcv.x : P0.x; dA.y = up ? rcv.y : P0.y; dA.z = up ? rcv.z : P0.z; dA.w = up ? rcv.w : P0.w;
    dB.x = up ? P1.x : rcv.x; dB.y = up ? P1.y : rcv.y; dB.z = up ? P1.z : rcv.z; dB.w = up ? P1.w : rcv.w;
    bf16_t* p = grp + (size_t)(fr & 7) * ld + (up ? CBJ : 0) + 8 * fq;
    __builtin_nontemporal_store(dA, (u32x4*)p); __builtin_nontemporal_store(dB, (u32x4*)(p + 8 * ld));
}
__device__ __forceinline__ void store_pair8(unsigned char* grp  , size_t ld, int fr, int fq, u32x2 P0, u32x2 P1) {
    const bool up = (fr & 8) != 0;
    u32x2 snd, rcv, dA, dB;
    snd.x = up ? P0.x : P1.x; snd.y = up ? P0.y : P1.y;
    rcv.x = dpp_ror8(snd.x); rcv.y = dpp_ror8(snd.y);
    dA.x = up ? rcv.x : P0.x; dA.y = up ? rcv.y : P0.y;
    dB.x = up ? P1.x : rcv.x; dB.y = up ? P1.y : rcv.y;
    unsigned char* p = grp + (size_t)(fr & 7) * ld + (up ? CBJ : 0) + 8 * fq;
    __builtin_nontemporal_store(dA, (u32x2*)p); __builtin_nontemporal_store(dB, (u32x2*)(p + 8 * ld));
}
__device__ __forceinline__ unsigned gate_byte(float g) { return (unsigned)(int)__builtin_amdgcn_fmed3f(__builtin_rintf(g * 255.0f), 1.0f, 255.0f); }
__device__ __forceinline__ void unpack8u(u32x2 w, f32x4& a, f32x4& b) {
    a = (f32x4){(float)(w.x & 255u), (float)((w.x >> 8) & 255u), (float)((w.x >> 16) & 255u), (float)(w.x >> 24)};
    b = (f32x4){(float)(w.y & 255u), (float)((w.y >> 8) & 255u), (float)((w.y >> 16) & 255u), (float)(w.y >> 24)};
}
__device__ __forceinline__ size_t g8_tile(int pm, int gt) { return ((size_t)pm * 24 + gt) * 65536; }
struct EpiIn {
    static constexpr bool PERM = true;
    bf16_t* P; const float* bgate;
    __device__ __forceinline__ void operator()(f32x4 (&acc)[2][2][4][2], const Unit& u, int wr, int wc, int fr, int fq) const {
        const int rowg = u.pm * BM + wr * 64, colw = u.pn * BM + wc * 64, col0 = colw + 8 * fq, grp = u.pn >> 2;
        const int mode = grp == 1 ? 1 : (grp == 5 ? 2 : (grp >= 6 ? 3 : 0));
#pragma unroll
        for (int ai = 0; ai < 2; ++ai)
#pragma unroll
            for (int m = 0; m < 4; ++m) {
                u32x4 pk[2];
#pragma unroll
                for (int bj = 0; bj < 2; ++bj) {
                    f32x4 v0 = acc[ai][bj][m][0], v1 = acc[ai][bj][m][1];
                    if (mode == 1) {
#pragma unroll
                        for (int j = 0; j < 4; ++j) { v0[j] = fgelu_tanh(v0[j]); v1[j] = fgelu_tanh(v1[j]); }
                    } else if (mode == 2) { v0 = v0 * (0.0625f * LOG2E); v1 = v1 * (0.0625f * LOG2E); }
                    else if (mode == 3) {
                        v0 = v0 + *(const f32x4*)(bgate + (col0 - C_GT) + bj * CBJ); v1 = v1 + *(const f32x4*)(bgate + (col0 - C_GT) + bj * CBJ + 4);
#pragma unroll
                        for (int j = 0; j < 4; ++j) { v0[j] = fsigmoid(v0[j]); v1[j] = fsigmoid(v1[j]); }
                    }
                    pk[bj] = pack8(v0, v1);
                }
                store_pair(P + (size_t)(rowg + ai * HALF + m * 16) * INC + colw, INC, fr, fq, pk[0], pk[1]);
            }
    }
};
struct EpiIn8 {
    static constexpr bool PERM = true;
    bf16_t* P; const float* bgate; const float* sa; const unsigned* cmax; unsigned char* G8;
    __device__ __forceinline__ void operator()(f32x4 (&acc)[2][2][4][2], const Unit& u, int wr, int wc, int fr, int fq) const {
        const int rowg = u.pm * BM + wr * 64, colw = u.pn * BM + wc * 64, col0 = colw + 8 * fq;
        const int grp = (u.pn + C_I8 / BM) >> 2, mode = grp >= 6 ? 3 : (grp == 5 ? 2 : 0);
        if (mode == 3) {
            f32x4 cn[4], bn[4];
#pragma unroll
            for (int k = 0; k < 4; ++k) { const u32x4 c_ = *(const u32x4*)(cmax + col0 + (k >> 1) * CBJ + (k & 1) * 4); const f32x4 b_ = *(const f32x4*)(bgate + (col0 + C_I8 - C_GT) + (k >> 1) * CBJ + (k & 1) * 4);
#pragma unroll
                for (int j = 0; j < 4; ++j) { cn[k][j] = __uint_as_float(c_[j]) * -LOG2E; bn[k][j] = b_[j] * -LOG2E; } }
            float sv[8];
#pragma unroll
            for (int k = 0; k < 8; ++k) sv[k] = sa[rowg + (k >> 2) * HALF + (k & 3) * 16 + fr] * (1.0f / 127.0f);
#pragma unroll
            for (int ai = 0; ai < 2; ++ai)
#pragma unroll
                for (int m = 0; m < 4; ++m) {
                    const float s = sv[ai * 4 + m];
                    u32x2 gb[2];
#pragma unroll
                    for (int bj = 0; bj < 2; ++bj) {
                        const v4i_t i0 = __builtin_bit_cast(v4i_t, acc[ai][bj][m][0]), i1 = __builtin_bit_cast(v4i_t, acc[ai][bj][m][1]);
                        unsigned w0 = 0u, w1 = 0u;
#pragma unroll
                        for (int j = 0; j < 4; ++j) {
                            const float e0 = __builtin_amdgcn_exp2f(__builtin_fmaf((float)i0[j], s * cn[bj * 2][j], bn[bj * 2][j])), e1 = __builtin_amdgcn_exp2f(__builtin_fmaf((float)i1[j], s * cn[bj * 2 + 1][j], bn[bj * 2 + 1][j]));
                            const float g0 = __builtin_amdgcn_rcpf(__builtin_fmaf(e0, 1.0f / 255.0f, 1.0f / 255.0f)), g1 = __builtin_amdgcn_rcpf(__builtin_fmaf(e1, 1.0f / 255.0f, 1.0f / 255.0f));
                            w0 = __builtin_amdgcn_cvt_pk_u8_f32(fmaxf(g0, 1.0f), j, w0); w1 = __builtin_amdgcn_cvt_pk_u8_f32(fmaxf(g1, 1.0f), j, w1);
                        }
                        gb[bj].x = w0; gb[bj].y = w1;
                    }
                    unsigned char* gq = G8 + g8_tile(u.pm, u.pn - (C_GT - C_I8) / BM) + (wr * 4 + wc) * 8192 + (ai * 4 + m) * 1024 + (fq * 16 + fr) * 8;
                    __builtin_nontemporal_store(gb[0], (u32x2*)gq); __builtin_nontemporal_store(gb[1], (u32x2*)(gq + 512));
                }
            return;
        }
        f32x4 cq[4]; float sq[8];
        const float qs = mode == 2 ? 0.0625f * LOG2E : 1.0f;
#pragma unroll
        for (int k = 0; k < 4; ++k) { const u32x4 c_ = *(const u32x4*)(cmax + col0 + (k >> 1) * CBJ + (k & 1) * 4);
#pragma unroll
            for (int j = 0; j < 4; ++j) cq[k][j] = __uint_as_float(c_[j]) * qs; }
#pragma unroll
        for (int k = 0; k < 8; ++k) sq[k] = sa[rowg + (k >> 2) * HALF + (k & 3) * 16 + fr] * (1.0f / 127.0f);
#pragma unroll
        for (int ai = 0; ai < 2; ++ai)
#pragma unroll
            for (int m = 0; m < 4; ++m) {
                const float s = sq[ai * 4 + m];
                u32x4 pk[2];
#pragma unroll
                for (int bj = 0; bj < 2; ++bj) {
                    const v4i_t i0 = __builtin_bit_cast(v4i_t, acc[ai][bj][m][0]), i1 = __builtin_bit_cast(v4i_t, acc[ai][bj][m][1]);
                    f32x4 v0, v1;
#pragma unroll
                    for (int j = 0; j < 4; ++j) { v0[j] = (float)i0[j] * (s * cq[bj * 2][j]); v1[j] = (float)i1[j] * (s * cq[bj * 2 + 1][j]); }
                    pk[bj] = pack8(v0, v1);
                }
                store_pair(P + (size_t)(rowg + ai * HALF + m * 16) * INC + C_I8 + colw, INC, fr, fq, pk[0], pk[1]);
            }
    }
};
struct EpiUp {
    static constexpr bool PERM = true;
    bf16_t* H;
    __device__ __forceinline__ void operator()(f32x4 (&acc)[2][2][4][2], const Unit& u, int wr, int wc, int fr, int fq) const {
        const int rowg = u.pm * BM + wr * 64, colw = u.pn * BM + wc * 64;
#pragma unroll
        for (int ai = 0; ai < 2; ++ai)
#pragma unroll
            for (int m = 0; m < 4; ++m) {
                u32x4 pk[2];
#pragma unroll
                for (int bj = 0; bj < 2; ++bj) {
                    f32x4 v0 = acc[ai][bj][m][0], v1 = acc[ai][bj][m][1];
#pragma unroll
                    for (int j = 0; j < 4; ++j) { const float a = fmaxf(v0[j], 0.f), b = fmaxf(v1[j], 0.f); v0[j] = a * a; v1[j] = b * b; }
                    pk[bj] = pack8(v0, v1);
                }
                store_pair(H + (size_t)(rowg + ai * HALF + m * 16) * DFF + colw, DFF, fr, fq, pk[0], pk[1]);
            }
    }
};
struct EpiUp8 {
    static constexpr bool PERM = true, WIDE = true;
    unsigned char* ws; int l, tl;
#define UP8_CTL  ((unsigned*)(ws + WS_CTL))
#define UP8_H8   (ws + WS_PROJ)
#define UP8_SA   ((const float*)(ws + WS_SA))
#define UP8_CMAX ((const unsigned*)(ws + WS_CTL) + CW_CMAX + l * CM_L + NI8)
#define UP8_RMAX (UP8_CTL + CW_RMAX + l * MT)
#define UP8_RCNT (UP8_CTL + CW_RCNT)
#define UP8_TMO  (UP8_CTL + 4096 + 128)
#define UP8_TGT  (128u * (unsigned)tl)
    __device__ __forceinline__ void wait_posts(unsigned* cnt, unsigned have) const {
        const unsigned target = UP8_TGT; unsigned* tmo = UP8_TMO; unsigned sp = 0; while (have < target) { __builtin_amdgcn_s_sleep(1); have = __hip_atomic_load(cnt, __ATOMIC_RELAXED, __HIP_MEMORY_SCOPE_AGENT);
            if ((++sp & 255u) == 0u) { if (__hip_atomic_load(tmo, __ATOMIC_RELAXED, __HIP_MEMORY_SCOPE_AGENT)) break; if (sp > (1u << 18)) { atomicAdd(tmo, 1u); break; } } }
        asm volatile("" ::: "memory");
    }
    __device__ __forceinline__ void load_rmax(int pm, int wr, int fr_in, float (&rmv)[8]) const {
        int fr = fr_in; asm volatile("" : "+v"(fr));
        const unsigned* rp = UP8_RMAX + pm * BM + wr * 64 + fr;
#pragma unroll
        for (int k = 0; k < 8; ++k) rmv[k] = __uint_as_float(__hip_atomic_load(rp + (k >> 2) * HALF + (k & 3) * 16, __ATOMIC_RELAXED, __HIP_MEMORY_SCOPE_AGENT));
    }
    __device__ __forceinline__ void operator()(f32x4 (&acc)[2][2][4][2], const Unit& u, int wr, int wc, int fr_in, int fq_in, int wid, LAS unsigned char* lds) const {
        int fr = fr_in, fq = fq_in; asm volatile("" : "+v"(fr), "+v"(fq));
        const float* sa = UP8_SA; const unsigned* cmax = UP8_CMAX; unsigned* rmax = UP8_RMAX; unsigned* rcnt = UP8_RCNT;
        const int rowg = u.pm * BM + wr * 64, colw = u.pn * BM + wc * 64, lane = fq * 16 + fr;
        unsigned* pcnt = rcnt + u.pm * 32;
        LAS float* lmx = (LAS float*)(lds + MISC_OFF + 1024);
        float sv[8]; u32x4 cv[4];
#pragma unroll
        for (int k = 0; k < 8; ++k) sv[k] = sa[rowg + (k >> 2) * HALF + (k & 3) * 16 + fr] * (1.0f / 127.0f);
#pragma unroll
        for (int k = 0; k < 4; ++k) cv[k] = *(const u32x4*)(cmax + colw + 8 * fq + (k >> 1) * CBJ + (k & 1) * 4);
#pragma unroll
        for (int ai = 0; ai < 2; ++ai)
#pragma unroll
            for (int m = 0; m < 4; ++m) {
                const float s = sv[ai * 4 + m];
                float mx = 0.f;
#pragma unroll
                for (int bj = 0; bj < 2; ++bj) {
                    const v4i_t i0 = __builtin_bit_cast(v4i_t, acc[ai][bj][m][0]), i1 = __builtin_bit_cast(v4i_t, acc[ai][bj][m][1]);
                    const u32x4 c0_ = cv[bj * 2], c1_ = cv[bj * 2 + 1];
                    f32x4 v0, v1;
#pragma unroll
                    for (int j = 0; j < 4; ++j) { const float a = fmaxf((float)i0[j] * (s * __uint_as_float(c0_[j])), 0.f), b = fmaxf((float)i1[j] * (s * __uint_as_float(c1_[j])), 0.f); v0[j] = a * a; v1[j] = b * b; mx = fmaxf(mx, fmaxf(v0[j], v1[j])); }
                    acc[ai][bj][m][0] = v0; acc[ai][bj][m][1] = v1;
                }
                mx = fmaxf(mx, __shfl_xor(mx, 16)); mx = fmaxf(mx, __shfl_xor(mx, 32));
                if (fq == 0) lmx[wc * 256 + wr * 64 + ai * HALF + m * 16 + fr] = mx;
            }
        LDS_WAIT(); __builtin_amdgcn_s_barrier();
        if (wid < 4) {
            const int r = wid * 64 + lane;
            const float m4 = fmaxf(fmaxf(lmx[r], lmx[256 + r]), fmaxf(lmx[512 + r], lmx[768 + r]));
            const unsigned old = __hip_atomic_fetch_max(rmax + u.pm * BM + r, __float_as_uint(m4), __ATOMIC_RELAXED, __HIP_MEMORY_SCOPE_AGENT);
            asm volatile("" :: "v"(old) : "memory");
            if (lane == 0) (void)__hip_atomic_fetch_add(pcnt, 1u, __ATOMIC_RELAXED, __HIP_MEMORY_SCOPE_AGENT);
        }
        LAS float* lfin = lmx + 1024;
        if (wid == 0) {
            wait_posts(pcnt, __hip_atomic_load(pcnt, __ATOMIC_RELAXED, __HIP_MEMORY_SCOPE_AGENT));
            unsigned fv[4];
#pragma unroll
            for (int k = 0; k < 4; ++k) fv[k] = __hip_atomic_load(rmax + u.pm * BM + k * 64 + lane, __ATOMIC_RELAXED, __HIP_MEMORY_SCOPE_AGENT);
#pragma unroll
            for (int k = 0; k < 4; ++k) lfin[k * 64 + lane] = __uint_as_float(fv[k]);
            LDS_WAIT();
        }
        __builtin_amdgcn_s_barrier();
        float rmv[8];
#pragma unroll
        for (int k = 0; k < 8; ++k) rmv[k] = lfin[wr * 64 + (k >> 2) * HALF + (k & 3) * 16 + fr];
        unsigned char* H8 = UP8_H8;
#pragma unroll
        for (int ai = 0; ai < 2; ++ai)
#pragma unroll
            for (int m = 0; m < 4; ++m) {
                const float rm = rmv[ai * 4 + m], inv = rm > 0.f ? 255.0f * __builtin_amdgcn_rcpf(rm) : 0.f;
                u32x2 gb[2];
#pragma unroll
                for (int bj = 0; bj < 2; ++bj) {
                    const f32x4 v0 = acc[ai][bj][m][0], v1 = acc[ai][bj][m][1];
                    unsigned w0 = 0u, w1 = 0u;
#pragma unroll
                    for (int j = 0; j < 4; ++j) { w0 = __builtin_amdgcn_cvt_pk_u8_f32(__builtin_rintf(v0[j] * inv), j, w0); w1 = __builtin_amdgcn_cvt_pk_u8_f32(__builtin_rintf(v1[j] * inv), j, w1); }
                    gb[bj].x = w0 ^ 0x80808080u; gb[bj].y = w1 ^ 0x80808080u;
                }
                store_pair8(H8 + (size_t)(rowg + ai * HALF + m * 16) * DFF + colw, DFF, fr, fq, gb[0], gb[1]);
            }
    }
#undef UP8_CTL
#undef UP8_H8
#undef UP8_SA
#undef UP8_CMAX
#undef UP8_RMAX
#undef UP8_RCNT
#undef UP8_TMO
#undef UP8_TGT
};
struct EpiY8 {
    static constexpr bool PERM = true;
    bf16_t* Y; float* ssy; float* yp; const unsigned* rmax; const unsigned* cmax; const int* csum;
    __device__ __forceinline__ void operator()(f32x4 (&acc)[2][2][4][2], const Unit& u, int wr, int wc, int fr, int fq) const {
        const int rowg = u.pm * BM + wr * 64, colw = u.pn * BM + wc * 64, row0 = rowg + fr, col0 = colw + 8 * fq;
        u32x4 cv[4]; v4i_t ov[4];
#pragma unroll
        for (int k = 0; k < 4; ++k) { cv[k] = *(const u32x4*)(cmax + col0 + (k >> 1) * CBJ + (k & 1) * 4); ov[k] = *(const v4i_t*)(csum + (u.ks < 0 ? 0 : (1 + u.ks) * DM) + col0 + (k >> 1) * CBJ + (k & 1) * 4); }
        float rv[8];
#pragma unroll
        for (int k = 0; k < 8; ++k) rv[k] = __uint_as_float(rmax[row0 + (k >> 2) * HALF + (k & 3) * 16]) * (1.0f / (255.0f * 127.0f));
#pragma unroll
        for (int ai = 0; ai < 2; ++ai)
#pragma unroll
            for (int m = 0; m < 4; ++m) {
                const int row = row0 + ai * HALF + m * 16;
                const float sr = rv[ai * 4 + m];
                float s = 0.f; u32x4 pk[2];
#pragma unroll
                for (int bj = 0; bj < 2; ++bj) {
                    const v4i_t i0 = __builtin_bit_cast(v4i_t, acc[ai][bj][m][0]) + ov[bj * 2], i1 = __builtin_bit_cast(v4i_t, acc[ai][bj][m][1]) + ov[bj * 2 + 1];
                    const u32x4 c0_ = cv[bj * 2], c1_ = cv[bj * 2 + 1];
                    f32x4 v0, v1;
#pragma unroll
                    for (int j = 0; j < 4; ++j) { v0[j] = (float)i0[j] * (sr * __uint_as_float(c0_[j])); v1[j] = (float)i1[j] * (sr * __uint_as_float(c1_[j])); }
                    s += (v0[0] * v0[0] + v0[1] * v0[1]) + (v0[2] * v0[2] + v0[3] * v0[3]) + (v1[0] * v1[0] + v1[1] * v1[1]) + (v1[2] * v1[2] + v1[3] * v1[3]);
                    pk[bj] = pack8(v0, v1);
                }
                if (u.ks >= 0) store_pair((bf16_t*)yp + ((size_t)u.ks * MS + (rowg - MP) + ai * HALF + m * 16) * DM + colw, DM, fr, fq, pk[0], pk[1]);
                else {
                    store_pair(Y + (size_t)(rowg + ai * HALF + m * 16) * DM + colw, DM, fr, fq, pk[0], pk[1]);
                    s += __shfl_xor(s, 16); s += __shfl_xor(s, 32);
                    if (fq == 0) ssy[(size_t)row * 32 + u.pn * 4 + wc] = s;
                }
            }
    }
};
struct EpiY {
    static constexpr bool PERM = true;
    bf16_t* Y; float* ssy; float* yp;
    __device__ __forceinline__ void operator()(f32x4 (&acc)[2][2][4][2], const Unit& u, int wr, int wc, int fr, int fq) const {
        const int rowg = u.pm * BM + wr * 64, colw = u.pn * BM + wc * 64, row0 = rowg + fr, col0 = colw + 8 * fq;
        if (u.ks >= 0) {
            bf16_t* base = (bf16_t*)yp + ((size_t)u.ks * MS + (rowg - MP)) * DM + colw;
#pragma unroll
            for (int ai = 0; ai < 2; ++ai)
#pragma unroll
                for (int m = 0; m < 4; ++m)
                    store_pair(base + (size_t)(ai * HALF + m * 16) * DM, DM, fr, fq, pack8(acc[ai][0][m][0], acc[ai][0][m][1]), pack8(acc[ai][1][m][0], acc[ai][1][m][1]));
            return;
        }
#pragma unroll
        for (int ai = 0; ai < 2; ++ai)
#pragma unroll
            for (int m = 0; m < 4; ++m) {
                const int row = row0 + ai * HALF + m * 16;
                float s = 0.f; u32x4 pk[2];
#pragma unroll
                for (int bj = 0; bj < 2; ++bj) {
                    const f32x4 v0 = acc[ai][bj][m][0], v1 = acc[ai][bj][m][1];
                    s += (v0[0] * v0[0] + v0[1] * v0[1]) + (v0[2] * v0[2] + v0[3] * v0[3]) + (v1[0] * v1[0] + v1[1] * v1[1]) + (v1[2] * v1[2] + v1[3] * v1[3]);
                    pk[bj] = pack8(v0, v1);
                }
                store_pair(Y + (size_t)(rowg + ai * HALF + m * 16) * DM + colw, DM, fr, fq, pk[0], pk[1]);
                s += __shfl_xor(s, 16); s += __shfl_xor(s, 32);
                if (fq == 0) ssy[(size_t)row * 32 + u.pn * 4 + wc] = s;
            }
    }
};
struct EpiBranch {
    static constexpr bool PERM = true;
    const unsigned char* G8; bf16_t* Mg;
    __device__ __forceinline__ void operator()(f32x4 (&acc)[2][2][4][2], const Unit& u, int wr, int wc, int fr, int fq) const {
        const int rowg = u.pm * BM + wr * 64, colw = u.pn * BM + wc * 64, row0 = rowg + fr, col0 = colw + 8 * fq, seg = u.seg;
        u32x2 gv[8][2], hv[8][2];
#pragma unroll
        for (int k = 0; k < 8; ++k) {
            const unsigned char* gp = G8 + g8_tile(u.pm, seg * 8 + u.pn) + (wr * 4 + wc) * 8192 + k * 1024 + (fq * 16 + fr) * 8;
#pragma unroll
            for (int bj = 0; bj < 2; ++bj) { gv[k][bj] = *(const u32x2*)(gp + bj * 512); if (seg < 2) hv[k][bj] = *(const u32x2*)(gp + 8 * 65536 + bj * 512); }
        }
#pragma unroll
        for (int ai = 0; ai < 2; ++ai)
#pragma unroll
            for (int m = 0; m < 4; ++m) {
                u32x4 pk[2];
#pragma unroll
                for (int bj = 0; bj < 2; ++bj) {
                    f32x4 g0, g1; unpack8u(gv[ai * 4 + m][bj], g0, g1);
                    if (seg < 2) {
                        f32x4 h0, h1; unpack8u(hv[ai * 4 + m][bj], h0, h1);
#pragma unroll
                        for (int j = 0; j < 4; ++j) { g0[j] = g0[j] * __builtin_amdgcn_rcpf(h0[j]); g1[j] = g1[j] * __builtin_amdgcn_rcpf(h1[j]); }
                        acc[ai][bj][m][0] = acc[ai][bj][m][0] * g0; acc[ai][bj][m][1] = acc[ai][bj][m][1] * g1;
                    } else pk[bj] = pack8(acc[ai][bj][m][0] * (g0 * (1.0f / 255.0f)), acc[ai][bj][m][1] * (g1 * (1.0f / 255.0f)));
                }
                if (seg == 2) store_pair(Mg + (size_t)(rowg + ai * HALF + m * 16) * DM + colw, DM, fr, fq, pk[0], pk[1]);
            }
    }
};
struct EpiPart {
    static constexpr bool PERM = true;
    float* bp;
    __device__ __forceinline__ void operator()(f32x4 (&acc)[2][2][4][2], const Unit& u, int wr, int wc, int fr, int fq) const {
        const int row0 = u.pm * BM + wr * 64 + fr, col0 = u.pn * BM + wc * 64 + 8 * fq;
        float* base = bp + ((size_t)u.seg * MS + (row0 - MP)) * DM + col0;
#pragma unroll
        for (int ai = 0; ai < 2; ++ai)
#pragma unroll
            for (int m = 0; m < 4; ++m)
#pragma unroll
                for (int bj = 0; bj < 2; ++bj) { float* op = base + (size_t)(ai * HALF + m * 16) * DM + bj * CBJ; *(f32x4*)op = acc[ai][bj][m][0]; *(f32x4*)(op + 4) = acc[ai][bj][m][1]; }
    }
};
struct EpiKV {
    static constexpr bool PERM = true;
    float* outk; float* outv; bf16_t* KP; bf16_t* VTP;
    __device__ __forceinline__ void operator()(f32x4 (&acc)[2][2][4][2], const Unit& u, int wr, int wc, int fr, int fq) const {
        const int row0 = u.pm * BM + wr * 64 + fr, l = u.pn >> 3, colL0 = (u.pn & 7) * BM + wc * 64 + 8 * fq;
        const bool isv = colL0 >= MW;
#pragma unroll
        for (int ai = 0; ai < 2; ++ai)
#pragma unroll
            for (int m = 0; m < 4; ++m) {
                const int row = row0 + ai * HALF + m * 16;
#pragma unroll
                for (int bj = 0; bj < 2; ++bj) {
                    const f32x4 v0 = acc[ai][bj][m][0], v1 = acc[ai][bj][m][1];
                    const int c = (colL0 + bj * CBJ) & (MW - 1);
                    float* op = (isv ? outv : outk) + (size_t)l * (512 * 1024) + (size_t)row * MW + c;
                    *(f32x4*)op = v0; *(f32x4*)(op + 4) = v1;
                    if (!isv) *(u32x4*)(KP + (size_t)l * (512 * 1024) + (size_t)row * MW + c) = pack8(v0, v1);
                    else {
                        const int b = row >> 8, key = row & 255, h = c >> 8, d = c & 255;
                        bf16_t* vp = VTP + ((size_t)((l * 2 + b) * 4 + h) * 256 + d) * 256 + key;
#pragma unroll
                        for (int j = 0; j < 4; ++j) { vp[(size_t)j * 256] = f2bf(v0[j]); vp[(size_t)(4 + j) * 256] = f2bf(v1[j]); }
                    }
                }
            }
    }
};
}

#define XB_TMO      128
#define XB_XCNT(j)  (256  + 64 * (j))
#define XB_XSUB(j)  (1280 + 64 * (j))
#define XB_XGEN(j)  (2304 + 64 * (j))
#define XB_TOP      3328
#define XB_TOPGEN   3392
#define XCD_BAR_WORDS 3456
#define XB_SPIN_CAP (1u << 18)
__device__ __forceinline__ unsigned xb_ld(unsigned* p)              { return __hip_atomic_load(p, __ATOMIC_RELAXED, __HIP_MEMORY_SCOPE_AGENT); }
__device__ __forceinline__ unsigned xb_add(unsigned* p, unsigned v) { return __hip_atomic_fetch_add(p, v, __ATOMIC_RELAXED, __HIP_MEMORY_SCOPE_AGENT); }
__device__ __forceinline__ unsigned xb_xcc_id() { return (unsigned)__builtin_amdgcn_s_getreg((3 << 11) | 20) & 0xFu; }
#define XB_SPIN(cond, bar) do { unsigned _sp = 0; while (cond) { __builtin_amdgcn_s_sleep(1); \
    if ((++_sp & 255u) == 0u) { if (xb_ld(&(bar)[XB_TMO])) break; if (_sp > XB_SPIN_CAP) { atomicAdd(&(bar)[XB_TMO], 1u); break; } } } } while (0)
struct XcdBarrier { unsigned* bar; unsigned x; volatile LAS unsigned* st; };
__device__ __forceinline__ XcdBarrier xcd_barrier_post(unsigned* bar, volatile LAS unsigned* st) {
    XcdBarrier b; b.bar = bar; b.x = xb_xcc_id(); b.st = st;
    if (threadIdx.x == 0) (void)xb_add(&bar[XB_XCNT(b.x)], 1u);
    return b;
}
__device__ __forceinline__ void xcd_barrier_complete(unsigned* bar, unsigned x, unsigned& nloc, unsigned& nx) {
    const unsigned G = gridDim.x * gridDim.y * gridDim.z;
    unsigned sum, cnt, mine, sp = 0u;
    for (;;) {
        sum = 0u; cnt = 0u; mine = 0u;
#pragma unroll
        for (unsigned j = 0; j < 16; ++j) { const unsigned c = xb_ld(&bar[XB_XCNT(j)]); sum += c; cnt += (c > 0u) ? 1u : 0u; mine = (j == x) ? c : mine; }
        if (sum == G) break;
        __builtin_amdgcn_s_sleep(1);
        if ((++sp & 255u) == 0u) { if (xb_ld(&bar[XB_TMO])) break; if (sp > XB_SPIN_CAP) { atomicAdd(&bar[XB_TMO], 1u); break; } }
    }
    nloc = mine > 0u ? mine : 1u; nx = cnt > 0u ? cnt : 1u;
}
__device__ __forceinline__ void xcd_barrier(const XcdBarrier& b) {
    asm volatile("s_waitcnt vmcnt(0)" ::: "memory");
    __syncthreads();
    if (threadIdx.x == 0) {
        unsigned* bar = b.bar;
        __builtin_amdgcn_s_waitcnt(0);
        unsigned nloc = b.st[0], nx = b.st[1];
        if (nloc == 0u) { xcd_barrier_complete(bar, b.x, nloc, nx); b.st[0] = nloc; b.st[1] = nx; }
        const unsigned old = xb_add(&bar[XB_XSUB(b.x)], 1u);
        const unsigned gen = old / nloc;
        if (old + 1u == (gen + 1u) * nloc) {
            __builtin_amdgcn_fence(__ATOMIC_RELEASE, "agent");
            asm volatile("s_waitcnt vmcnt(0)" ::: "memory");
            const unsigned og = xb_add(&bar[XB_TOP], 1u);
            const unsigned tg = og / nx;
            if (og + 1u == (tg + 1u) * nx) xb_add(&bar[XB_TOPGEN], 1u);
            else XB_SPIN(xb_ld(&bar[XB_TOPGEN]) == tg, bar);
            __builtin_amdgcn_fence(__ATOMIC_ACQUIRE, "agent");
            xb_add(&bar[XB_XGEN(b.x)], 1u);
            asm volatile("s_waitcnt vmcnt(0)" ::: "memory");
        } else {
            XB_SPIN(xb_ld(&bar[XB_XGEN(b.x)]) == gen, bar);
            __builtin_amdgcn_fence(__ATOMIC_ACQUIRE, "agent");
            asm volatile("s_waitcnt vmcnt(0)" ::: "memory");
        }
    }
    __syncthreads();
}

struct TItem { const float* W; bf16_t* WT; const float* scale; int K, N, r, nblk, noff, kind; const unsigned* cmax; int* csum; };
__device__ __forceinline__ void titem_load(const TItem& t, f32x4 (&x)[16], float (&sc)[16], int lane) {
    const int nblk = t.nblk, kb = t.r / nblk, nb = t.r - kb * nblk, k0 = 64 * kb, n0 = t.noff + 64 * nb, c = lane & 15, r = lane >> 4;
#pragma unroll
    for (int i = 0; i < 16; ++i) { const int kk = t.kind ? 16 * (i >> 2) + 4 * r + (i & 3) : 8 * (i >> 1) + 2 * r + (i & 1); x[i] = __builtin_nontemporal_load((const f32x4*)(t.W + (size_t)(k0 + kk) * t.N + n0 + 4 * c)); sc[i] = t.scale ? t.scale[k0 + kk] : 1.0f; }
}
__device__ __forceinline__ void titem_finish(const TItem& t, const f32x4 (&x)[16], const float (&sc)[16], LAS float* scr_f, int lane) {
    LAS unsigned* scr = (LAS unsigned*)scr_f;
    const int nblk = t.nblk, kb = t.r / nblk, nb = t.r - kb * nblk, k0 = 64 * kb, n0 = t.noff + 64 * nb, c = lane & 15, r = lane >> 4;
    if (t.kind) {
        float inv[4];
#pragma unroll
        for (int e = 0; e < 4; ++e) inv[e] = 127.0f / fmaxf(__uint_as_float(t.cmax[n0 - t.noff + 4 * c + e]), 1e-30f);
#pragma unroll
        for (int p = 0; p < 4; ++p)
#pragma unroll
            for (int e = 0; e < 4; ++e) {
                unsigned w = 0;
#pragma unroll
                for (int j = 0; j < 4; ++j) { const float v = __builtin_amdgcn_fmed3f(__builtin_rintf(x[4 * p + j][e] * sc[4 * p + j] * inv[e]), -127.f, 127.f); w |= ((unsigned)(int)v & 255u) << (8 * j); }
                scr[(4 * c + e) * 17 + 4 * p + r] = w;
            }
        LDS_WAIT(); asm volatile("" ::: "memory");
        const int q4 = lane & 3;
#pragma unroll
        for (int j = 0; j < 4; ++j) { const int n = (lane >> 2) + 16 * j; const LAS unsigned* s = scr + n * 17 + 4 * q4;
            u32x4 o; o.x = s[0]; o.y = s[1]; o.z = s[2]; o.w = s[3];
            *(u32x4*)((unsigned char*)t.WT + (size_t)(n0 - t.noff + n) * t.K + k0 + 16 * q4) = o;
            if (t.csum) {
                int cs = __builtin_amdgcn_sdot4((int)o.x, 0x01010101, 0, false); cs = __builtin_amdgcn_sdot4((int)o.y, 0x01010101, cs, false); cs = __builtin_amdgcn_sdot4((int)o.z, 0x01010101, cs, false); cs = __builtin_amdgcn_sdot4((int)o.w, 0x01010101, cs, false);
                cs += __shfl_xor(cs, 1); cs += __shfl_xor(cs, 2);
                if (q4 == 0) { atomicAdd(t.csum + n0 - t.noff + n, cs * 128); atomicAdd(t.csum + (1 + (k0 >> 10)) * DM + n0 - t.noff + n, cs * 128); }
            } }
        LDS_WAIT(); asm volatile("" ::: "memory");
        return;
    }
#pragma unroll
    for (int p = 0; p < 8; ++p)
#pragma unroll
        for (int e = 0; e < 4; ++e) scr[(4 * c + e) * 33 + 4 * p + r] = cvtpk(x[2 * p][e] * sc[2 * p], x[2 * p + 1][e] * sc[2 * p + 1]);
    LDS_WAIT(); asm volatile("" ::: "memory");
    const int q = lane & 7;
#pragma unroll
    for (int j = 0; j < 8; ++j) { const int n = (lane >> 3) + 8 * j; const LAS unsigned* s = scr + n * 33 + 4 * q;
        u32x4 o; o.x = s[0]; o.y = s[1]; o.z = s[2]; o.w = s[3];
        *(u32x4*)(t.WT + (size_t)(n0 + n) * t.K + k0 + 8 * q) = o; }
    LDS_WAIT(); asm volatile("" ::: "memory");
}
__device__ __forceinline__ void row_quant8(const f32x4 (&n0)[4], const f32x4 (&n1)[4], float mul, unsigned char* qrow, float* sa, int lane) {
    float am = 0.f;
#pragma unroll
    for (int j = 0; j < 4; ++j)
#pragma unroll
        for (int e = 0; e < 4; ++e) am = fmaxf(am, fmaxf(__builtin_fabsf(n0[j][e]), __builtin_fabsf(n1[j][e])));
#pragma unroll
    for (int o = 1; o < 64; o <<= 1) am = fmaxf(am, __shfl_xor(am, o));
    am *= mul;
    const float inv = am > 0.f ? 127.0f / am : 0.f, k = inv * mul;
#pragma unroll
    for (int j = 0; j < 4; ++j) {
        u32x2 w; w.x = 0; w.y = 0;
#pragma unroll
        for (int e = 0; e < 4; ++e) { const float a = __builtin_amdgcn_fmed3f(__builtin_rintf(n0[j][e] * k), -127.f, 127.f), b = __builtin_amdgcn_fmed3f(__builtin_rintf(n1[j][e] * k), -127.f, 127.f);
            w.x |= ((unsigned)(int)a & 255u) << (8 * e); w.y |= ((unsigned)(int)b & 255u) << (8 * e); }
        *(u32x2*)(qrow + j * 512 + lane * 8) = w;
    }
    if (lane == 0) *sa = am * (1.0f / 127.0f);
}

__device__ __forceinline__ float row_to_bf16_normed(const float* xrow, bf16_t* orow, int lane, unsigned char* qrow = nullptr, float* sa = nullptr) {
    f32x4 a[4], b[4]; float ss = 0.f;
#pragma unroll
    for (int j = 0; j < 4; ++j) {
        a[j] = *(const f32x4*)(xrow + j * 512 + lane * 8); b[j] = *(const f32x4*)(xrow + j * 512 + lane * 8 + 4);
        ss += (a[j][0] * a[j][0] + a[j][1] * a[j][1]) + (a[j][2] * a[j][2] + a[j][3] * a[j][3]) + (b[j][0] * b[j][0] + b[j][1] * b[j][1]) + (b[j][2] * b[j][2] + b[j][3] * b[j][3]);
    }
    const float ms = wave_sum(ss) * (1.0f / DM) + EPS, rs = __builtin_amdgcn_rsqf(ms);
#pragma unroll
    for (int j = 0; j < 4; ++j) *(u32x4*)(orow + j * 512 + lane * 8) = pack8(a[j] * rs, b[j] * rs);
    if (qrow) row_quant8(a, b, rs, qrow, sa, lane);
    return __builtin_sqrtf(ms);
}

struct Args { const float* in[30]; float* out; unsigned char* ws; int ph_lo, ph_hi; };
enum { I_XP = 0, I_XS, I_MEM, I_SLH, I_SLC, I_SSC, I_CK, I_CV, I_GMIXPRE, I_WIN, I_BGATE, I_LCW, I_LCB, I_LWA, I_LBA, I_LWI, I_LBI, I_LAM, I_WBL, I_SCW, I_WBC, I_GMEM, I_WKV, I_WBM, I_WOUT,
       I_GMIXPOST, I_GMLPPRE, I_WUP, I_WDN, I_GMLPPOST };
constexpr int NPH = 1 + 9 * DEPTH;
constexpr int CV_B = 7800;

constexpr int IT_IN = (DM / 64) * (INC / 64), IT_BR = (1024 / 64) * (DM / 64), IT_OUT = (DM / 64) * (DM / 64), IT_UP = (DM / 64) * (DFF / 64), IT_DN = (DFF / 64) * (DM / 64), IT_KV = IT_OUT;
constexpr int IT_LW = IT_IN + 3 * IT_BR + IT_OUT + IT_UP + IT_DN, IT_W = DEPTH * IT_LW, IT_KVA = DEPTH * IT_KV, IT_V = (MEMLEN / 64) * (MW / 64), IT_ALL = IT_W + IT_KVA;
template <bool FULL> __device__ __forceinline__ TItem decode_item(const Args& args, int it) {
    unsigned char* ws = args.ws; TItem t;
    if (FULL) if (it >= IT_W + IT_KVA) { const int v = it - IT_W - IT_KVA, mb = v / IT_V; t.W = args.in[I_CV] + (size_t)mb * MEMLEN * MW; t.K = MEMLEN; t.N = MW; t.nblk = MW / 64; t.noff = 0; t.kind = 0; t.cmax = nullptr; t.csum = nullptr; t.WT = (bf16_t*)(ws + WS_VTS) + (size_t)mb * MEMLEN * MW; t.scale = nullptr; t.r = v - mb * IT_V; return t; }
    if (FULL) if (it >= IT_W) { const int v = it - IT_W, l = v / IT_KV; t.W = args.in[I_WKV] + (size_t)l * DM * DM; t.K = DM; t.N = DM; t.nblk = DM / 64; t.noff = 0; t.kind = 0; t.cmax = nullptr; t.csum = nullptr; t.WT = (bf16_t*)(ws + WS_WKV + l * SZ_WOUT); t.scale = args.in[I_GMEM] + l * DM; t.r = v - l * IT_KV; return t; }
    const int l = it / IT_LW; int r = it - l * IT_LW;
    t.noff = 0; t.kind = 0; t.cmax = nullptr; t.csum = nullptr;
    if (r < IT_IN) {
        constexpr int IT_INB = (DM / 64) * (C_I8 / 64);
        const bool q = r >= IT_INB;
        t.W = args.in[I_WIN] + (size_t)l * DM * INC; t.K = DM; t.N = INC; t.nblk = q ? NI8 / 64 : C_I8 / 64; t.scale = args.in[I_GMIXPRE] + l * DM; t.r = q ? r - IT_INB : r;
        t.noff = q ? C_I8 : 0; t.kind = q ? 1 : 0; t.WT = (bf16_t*)(ws + WS_WIN + l * SZ_WIN + (q ? WQ_OFF : 0));
        t.cmax = (const unsigned*)(ws + WS_CTL) + CW_CMAX + l * CM_L;
        return t; } r -= IT_IN;
    if (r < 3 * IT_BR) { const int s = r / IT_BR; t.W = args.in[s == 0 ? I_WBL : (s == 1 ? I_WBC : I_WBM)] + (size_t)l * 1024 * DM; t.K = 1024; t.N = DM; t.nblk = DM / 64; t.WT = (bf16_t*)(ws + WS_WBR + (l * 3 + s) * SZ_WBR1); t.scale = nullptr; t.r = r - s * IT_BR; return t; } r -= 3 * IT_BR;
    if (r < IT_OUT) { t.W = args.in[I_WOUT] + (size_t)l * DM * DM; t.K = DM; t.N = DM; t.nblk = DM / 64; t.WT = (bf16_t*)(ws + WS_WOUT + l * SZ_WOUT); t.scale = nullptr; t.r = r; return t; } r -= IT_OUT;
    if (r < IT_UP) { t.W = args.in[I_WUP] + (size_t)l * DM * DFF; t.K = DM; t.N = DFF; t.nblk = DFF / 64; t.WT = (bf16_t*)(ws + WS_WUP + l * SZ_WUP); t.scale = args.in[I_GMLPPRE] + l * DM; t.r = r; t.kind = 1; t.cmax = (const unsigned*)(ws + WS_CTL) + CW_CMAX + l * CM_L + NI8; return t; } r -= IT_UP;
    t.W = args.in[I_WDN] + (size_t)l * DFF * DM; t.K = DFF; t.N = DM; t.nblk = DM / 64; t.WT = (bf16_t*)(ws + WS_WDN + l * SZ_WUP); t.scale = nullptr; t.r = r; t.kind = 1;
    t.cmax = (const unsigned*)(ws + WS_CTL) + CW_CMAX + l * CM_L + NI8 + DFF; t.csum = (int*)(ws + WS_CTL) + cw_csum9(l); return t;
}
template <bool FULL> __device__ __forceinline__ void conv_stream(const Args& args, LAS float* scr, int lane_in, int it0, int it1, int w, int nw, int jump_at = 0x7fffffff, int jump_by = 0) {
    int lane = lane_in; asm volatile("" : "+v"(lane));
    int it = it0 + w;
    if (it >= it1) return;
    TItem cur = decode_item<FULL>(args, it < jump_at ? it : it + jump_by); f32x4 xc[16]; float sc[16];
    titem_load(cur, xc, sc, lane);
    for (;;) {
        const int nit = it + nw; const bool more = nit < it1;
        TItem nxt = cur; f32x4 xn[16]; float sn[16];
        if (more) { nxt = decode_item<FULL>(args, nit < jump_at ? nit : nit + jump_by); titem_load(nxt, xn, sn, lane); }
        titem_finish(cur, xc, sc, scr, lane);
        if (!more) break;
#pragma unroll
        for (int i = 0; i < 16; ++i) { xc[i] = xn[i]; sc[i] = sn[i]; }
        cur = nxt; it = nit;
    }
}

template <bool FINAL, bool SMP>
__device__ __forceinline__ void lru_unit(const Args& args, int l, int p, int h, LAS unsigned char* lds, int wave, int lane) {
    asm volatile("" : "+v"(lane));
    unsigned char* ws = args.ws;
    const bf16_t* PROJ = (const bf16_t*)(ws + WS_PROJ);
    const int r16 = lane & 15, g = lane >> 4;
    const int b = SMP ? (p - 64) * 8 + wave : (p >> 5);
    const int t0 = SMP ? 0 : ((p & 31) * 256 + 32 * wave);
    const int R0 = p * 256 + 32 * wave;
    LAS float* WA = (LAS float*)lds; LAS float* WB = WA + 8 * 64; LAS float* HIN = WB + 8 * 64;
    u32x4 xr[2][2][4];
    f32x4 cwv[2][4][2], cbv[2][2];
    {
        const float* cw = args.in[I_LCW] + (size_t)l * 4 * LW; const float* cb = args.in[I_LCB] + (size_t)l * LW;
#pragma unroll
        for (int ks = 0; ks < 2; ++ks) {
            const int c0 = h * 64 + 32 * ks + 8 * g;
#pragma unroll
            for (int mt = 0; mt < 2; ++mt)
#pragma unroll
                for (int k = 0; k < 4; ++k) { const int rr = R0 + 16 * mt + r16 + k - 3; const bf16_t* src = PROJ + (size_t)(rr < 0 ? 0 : rr) * INC + C_LX + c0;
                    if (SMP && mt == 0 && k < 3) { const int ts = r16 + k - 3; const bf16_t* alt = (const bf16_t*)(ws + WS_SLCB) + ((size_t)(l * DBATCH + b) * 3 + (ts < 0 ? 3 + ts : 0)) * LW + c0; src = ts < 0 ? alt : src; }
                    xr[ks][mt][k] = *(const u32x4*)src; }
#pragma unroll
            for (int k = 0; k < 4; ++k) { cwv[ks][k][0] = *(const f32x4*)(cw + k * LW + c0); cwv[ks][k][1] = *(const f32x4*)(cw + k * LW + c0 + 4); }
            cbv[ks][0] = *(const f32x4*)(cb + c0); cbv[ks][1] = *(const f32x4*)(cb + c0 + 4);
        }
    }
    bf16x8 Af[2][2];
#pragma unroll
        for (int mt = 0; mt < 2; ++mt) {
            f32x4 u0 = cbv[0][0], u1 = cbv[0][1];
#pragma unroll
            for (int k = 0; k < 4; ++k) {
                const int ts = t0 + 16 * mt + r16 + k - 3;
                f32x4 x0, x1; unpack8(xr[0][mt][k], x0, x1);
                if (!SMP) { const float keep = ts < 0 ? 0.f : 1.f; x0 = x0 * keep; x1 = x1 * keep; }
                u0 += cwv[0][k][0] * x0; u1 += cwv[0][k][1] * x1;
            }
            Af[mt][0] = __builtin_bit_cast(bf16x8, pack8(u0, u1));
        }
    asm volatile("" ::: "memory");
    bf16x8 fa[4][2], fi[4][2];
    float bav[4], biv[4], lamv[4];
    {
        const bf16_t* WAT = (const bf16_t*)(ws + WS_WAT) + ((size_t)(l * LHEADS + h) * 64) * 64;
        const bf16_t* WIT = (const bf16_t*)(ws + WS_WIT) + ((size_t)(l * LHEADS + h) * 64) * 64;
        const float* ba = args.in[I_LBA] + (size_t)l * LW; const float* bi = args.in[I_LBI] + (size_t)l * LW; const float* c8t = (const float*)(ws + WS_PA) + (size_t)l * LW;
#pragma unroll
        for (int nt = 0; nt < 4; ++nt) {
#pragma unroll
            for (int ks = 0; ks < 2; ++ks) { const int n = 16 * nt + r16, k0 = 32 * ks + 8 * g; fa[nt][ks] = *(const bf16x8*)(WAT + n * 64 + k0); fi[nt][ks] = *(const bf16x8*)(WIT + n * 64 + k0); }
            const int ch = h * 64 + 16 * nt + r16; bav[nt] = ba[ch]; biv[nt] = bi[ch]; lamv[nt] = c8t[ch];
        }
    }
    asm volatile("" ::: "memory");
#pragma unroll
        for (int mt = 0; mt < 2; ++mt) {
            f32x4 u0 = cbv[1][0], u1 = cbv[1][1];
#pragma unroll
            for (int k = 0; k < 4; ++k) {
                const int ts = t0 + 16 * mt + r16 + k - 3;
                f32x4 x0, x1; unpack8(xr[1][mt][k], x0, x1);
                if (!SMP) { const float keep = ts < 0 ? 0.f : 1.f; x0 = x0 * keep; x1 = x1 * keep; }
                u0 += cwv[1][k][0] * x0; u1 += cwv[1][k][1] * x1;
            }
            Af[mt][1] = __builtin_bit_cast(bf16x8, pack8(u0, u1));
        }
    f32x4 Da[2][4], Di[2][4], Du[2][4];
#pragma unroll
    for (int nt = 0; nt < 4; ++nt) {
#pragma unroll
        for (int mt = 0; mt < 2; ++mt) { Da[mt][nt] = (f32x4){0.f, 0.f, 0.f, 0.f}; Di[mt][nt] = Da[mt][nt]; Du[mt][nt] = Da[mt][nt]; }
#pragma unroll
        for (int ks = 0; ks < 2; ++ks) {
            const int n = 16 * nt + r16, k0 = 32 * ks + 8 * g;
            bf16x8 id;
#pragma unroll
            for (int j = 0; j < 8; ++j) id[j] = (k0 + j == n) ? (short)0x3F80 : (short)0;
#pragma unroll
            for (int mt = 0; mt < 2; ++mt) {
                Da[mt][nt] = __builtin_amdgcn_mfma_f32_16x16x32_bf16(Af[mt][ks], fa[nt][ks], Da[mt][nt], 0, 0, 0);
                Di[mt][nt] = __builtin_amdgcn_mfma_f32_16x16x32_bf16(Af[mt][ks], fi[nt][ks], Di[mt][nt], 0, 0, 0);
                Du[mt][nt] = __builtin_amdgcn_mfma_f32_16x16x32_bf16(Af[mt][ks], id, Du[mt][nt], 0, 0, 0);
            }
        }
    }
    float totA[4], totB[4];
#pragma unroll
    for (int nt = 0; nt < 4; ++nt) {
        const float c8 = lamv[nt];
        float cA = 1.f, cB = 0.f;
#pragma unroll
        for (int mt = 0; mt < 2; ++mt) {
            float av[4], bv[4];
#pragma unroll
            for (int j = 0; j < 4; ++j) {
                const float r = fsigmoid(Da[mt][nt][j] + bav[nt]), ig = fsigmoid(Di[mt][nt][j] + biv[nt]);
                const float a = __builtin_amdgcn_exp2f(-LOG2E * c8 * r);
                av[j] = a; bv[j] = __builtin_amdgcn_sqrtf(fmaxf(1.0f - a * a, 0.f)) * (ig * Du[mt][nt][j]);
            }
            float pA[4], pB[4];
            pA[0] = av[0]; pB[0] = bv[0];
#pragma unroll
            for (int j = 1; j < 4; ++j) { pA[j] = pA[j - 1] * av[j]; pB[j] = av[j] * pB[j - 1] + bv[j]; }
            float tA[4], tB[4];
#pragma unroll
            for (int gg = 0; gg < 4; ++gg) { tA[gg] = __shfl(pA[3], r16 + 16 * gg); tB[gg] = __shfl(pB[3], r16 + 16 * gg); }
            float eA = cA, eB = cB;
#pragma unroll
            for (int gg = 0; gg < 3; ++gg) { const bool on = gg < g; const float nB = tA[gg] * eB + tB[gg], nA = eA * tA[gg]; eB = on ? nB : eB; eA = on ? nA : eA; }
#pragma unroll
            for (int j = 0; j < 4; ++j) { Da[mt][nt][j] = eA * pA[j]; Di[mt][nt][j] = pA[j] * eB + pB[j]; }
#pragma unroll
            for (int gg = 0; gg < 4; ++gg) { cB = tA[gg] * cB + tB[gg]; cA = cA * tA[gg]; }
        }
        totA[nt] = cA; totB[nt] = cB;
    }
    if (!FINAL) {
        if (g == 0) {
#pragma unroll
            for (int nt = 0; nt < 4; ++nt) { WA[wave * 64 + 16 * nt + r16] = totA[nt]; WB[wave * 64 + 16 * nt + r16] = totB[nt]; }
        }
        __syncthreads();
        if (wave == 0) {
            float A = 1.f, B = 0.f;
#pragma unroll
            for (int w = 0; w < 8; ++w) { const float a = WA[w * 64 + lane], bq = WB[w * 64 + lane]; B = a * B + bq; A = A * a; }
            float* PA = (float*)(ws + WS_PA); float* PB = (float*)(ws + WS_PB);
            const size_t o = ((size_t)b * 32 + (p & 31)) * LW + h * 64 + lane;
            PA[o] = A; PB[o] = B;
        }
        __syncthreads();
        return;
    }
    float hs[4];
    if (SMP) {
        const float* h0 = args.in[I_SLH] + ((size_t)l * DBATCH + b) * LW;
#pragma unroll
        for (int nt = 0; nt < 4; ++nt) hs[nt] = h0[h * 64 + 16 * nt + r16];
    } else {
        if (g == 0) {
#pragma unroll
            for (int nt = 0; nt < 4; ++nt) { WA[wave * 64 + 16 * nt + r16] = totA[nt]; WB[wave * 64 + 16 * nt + r16] = totB[nt]; }
        }
        __syncthreads();
        {
            typedef unsigned long long u64;
            const unsigned tag = (unsigned)l + 1u; const int np = p & 31;
            u64* gr = (u64*)(ws + WS_GRAN) + ((size_t)(b * 32) * LW + h * 64 + lane) * 2;
            if (wave == 0) {
                float A = 1.f, B = 0.f;
#pragma unroll
                for (int w = 0; w < 8; ++w) { const float a = WA[w * 64 + lane], bq = WB[w * 64 + lane]; B = a * B + bq; A = A * a; }
                __hip_atomic_store(gr + (size_t)np * LW * 2, ((u64)tag << 32) | __float_as_uint(A), __ATOMIC_RELAXED, __HIP_MEMORY_SCOPE_AGENT);
                __hip_atomic_store(gr + (size_t)np * LW * 2 + 1, ((u64)tag << 32) | __float_as_uint(B), __ATOMIC_RELAXED, __HIP_MEMORY_SCOPE_AGENT);
            }
            float pA = 1.f, pB = 0.f;
            if (4 * wave < np) {
                u64 va[4], vb[4]; unsigned spins = 0;
                for (;;) {
                    bool ok = true;
#pragma unroll
                    for (int k = 0; k < 4; ++k) { const int q = (4 * wave + k < np) ? 4 * wave + k : 4 * wave;
                        va[k] = __hip_atomic_load(gr + (size_t)q * LW * 2, __ATOMIC_RELAXED, __HIP_MEMORY_SCOPE_AGENT); vb[k] = __hip_atomic_load(gr + (size_t)q * LW * 2 + 1, __ATOMIC_RELAXED, __HIP_MEMORY_SCOPE_AGENT); }
#pragma unroll
                    for (int k = 0; k < 4; ++k) ok = ok && (unsigned)(va[k] >> 32) == tag && (unsigned)(vb[k] >> 32) == tag;
                    if (__all(ok) || ++spins > (1u << 16)) break;
                    __builtin_amdgcn_s_sleep(2);
                }
#pragma unroll
                for (int k = 0; k < 4; ++k) if (4 * wave + k < np) { const float a = __uint_as_float((unsigned)va[k]), bq = __uint_as_float((unsigned)vb[k]); pB = a * pB + bq; pA = pA * a; }
            }
            HIN[wave * 64 + lane] = pA; HIN[512 + wave * 64 + lane] = pB;
        }
        __syncthreads();
#pragma unroll
        for (int nt = 0; nt < 4; ++nt) {
            const int c = 16 * nt + r16; float hv = 0.f;
#pragma unroll
            for (int w = 0; w < 8; ++w) hv = HIN[w * 64 + c] * hv + HIN[512 + w * 64 + c];
#pragma unroll
            for (int w = 0; w < 7; ++w) { const float nv = WA[w * 64 + c] * hv + WB[w * 64 + c]; hv = w < wave ? nv : hv; }
            hs[nt] = hv;
        }
    }
    bf16_t gt[2][4][4];
    const unsigned go0 = (unsigned)(((R0 + 4 * g) * INC + C_LG + h * 64 + r16) * 2);
    const unsigned so0 = (unsigned)(((R0 + 4 * g) * LW + h * 64 + r16) * 2);
    asm volatile("" ::: "memory");
    if (FINAL) {
#pragma unroll
        for (int nt = 0; nt < 4; ++nt)
#pragma unroll
            for (int mt = 0; mt < 2; ++mt)
#pragma unroll
                for (int j = 0; j < 4; ++j) gt[mt][nt][j] = *(const bf16_t*)((const char*)PROJ + (go0 + (unsigned)((16 * mt + j) * (INC * 2) + 32 * nt)));
    }
    bf16_t* ALRU = (bf16_t*)(ws + WS_ABR);
    const bool lastw = SMP || ((p & 31) == 31 && wave == 7);
    float* hout = SMP ? args.out + O_SLH + ((size_t)l * DBATCH + b) * LW : args.out + O_PLH + ((size_t)l * NBATCH + b) * LW;
#pragma unroll
    for (int nt = 0; nt < 4; ++nt) {
        const int ch = h * 64 + 16 * nt + r16;
#pragma unroll
        for (int mt = 0; mt < 2; ++mt)
#pragma unroll
            for (int j = 0; j < 4; ++j) {
                const float hv = Da[mt][nt][j] * hs[nt] + Di[mt][nt][j];
                *(bf16_t*)((char*)ALRU + (so0 + (unsigned)((16 * mt + j) * (LW * 2) + 32 * nt))) = f2bf(hv * bf1(gt[mt][nt][j]));
                if (lastw && mt == 1 && j == 3 && g == 3) hout[ch] = hv;
            }
    }
    if (!SMP) __syncthreads();
}

__device__ __forceinline__ void sconv_item(const Args& args, int l, int item, int lane) {
    asm volatile("" : "+v"(lane));
    unsigned char* ws = args.ws;
    const bf16_t* PROJ = (const bf16_t*)(ws + WS_PROJ); bf16_t* ACONV = (bf16_t*)(ws + WS_ABR + SZ_ABR1);
    const int tb = item >> 1, c0 = (item & 1) * 512 + lane * 8, row0 = tb * 8;
    const bool smp = row0 >= MP;
    const int b = smp ? (row0 - MP) / DSEQ : row0 / SEQ, t0 = smp ? (row0 - MP) % DSEQ : row0 % SEQ, T = smp ? DSEQ : SEQ;
    const float* cw = args.in[I_SCW] + (size_t)l * 3 * LW + c0;
    f32x4 w[3][2];
#pragma unroll
    for (int k = 0; k < 3; ++k) { w[k][0] = *(const f32x4*)(cw + k * LW); w[k][1] = *(const f32x4*)(cw + k * LW + 4); }
    f32x4 zm2[2], zm1[2];
    if (t0 > 0) {
        f32x4 a0, a1, b0, b1;
        unpack8(*(const u32x4*)(PROJ + (size_t)(row0 - 2) * INC + C_SC + c0), a0, a1); unpack8(*(const u32x4*)(PROJ + (size_t)(row0 - 2) * INC + C_SH + c0), b0, b1); zm2[0] = a0 * b0; zm2[1] = a1 * b1;
        unpack8(*(const u32x4*)(PROJ + (size_t)(row0 - 1) * INC + C_SC + c0), a0, a1); unpack8(*(const u32x4*)(PROJ + (size_t)(row0 - 1) * INC + C_SH + c0), b0, b1); zm1[0] = a0 * b0; zm1[1] = a1 * b1;
    } else if (smp) {
        const float* sb = args.in[I_SSC] + ((size_t)l * DBATCH + b) * 2 * LW + c0;
        zm2[0] = *(const f32x4*)sb; zm2[1] = *(const f32x4*)(sb + 4); zm1[0] = *(const f32x4*)(sb + LW); zm1[1] = *(const f32x4*)(sb + LW + 4);
    } else { zm2[0] = (f32x4){0.f, 0.f, 0.f, 0.f}; zm2[1] = zm2[0]; zm1[0] = zm2[0]; zm1[1] = zm2[0]; }
#pragma unroll
    for (int i = 0; i < 8; ++i) {
        const bf16_t* pr = PROJ + (size_t)(row0 + i) * INC + c0;
        f32x4 a0, a1, b0, b1, s0, s1;
        unpack8(*(const u32x4*)(pr + C_SC), a0, a1); unpack8(*(const u32x4*)(pr + C_SH), b0, b1); unpack8(*(const u32x4*)(pr + C_SB), s0, s1);
        const f32x4 z0 = a0 * b0, z1 = a1 * b1;
        const f32x4 cv0 = w[0][0] * zm2[0] + w[1][0] * zm1[0] + w[2][0] * z0, cv1 = w[0][1] * zm2[1] + w[1][1] * zm1[1] + w[2][1] * z1;
        *(u32x4*)(ACONV + (size_t)(row0 + i) * LW + c0) = pack8(s0 * cv0, s1 * cv1);
        zm2[0] = zm1[0]; zm2[1] = zm1[1]; zm1[0] = z0; zm1[1] = z1;
    }
    if (t0 + 8 == T) {
        float* so = smp ? args.out + O_SSC + ((size_t)l * DBATCH + b) * 2 * LW + c0 : args.out + O_PSC + ((size_t)l * NBATCH + b) * 2 * LW + c0;
        *(f32x4*)so = zm2[0]; *(f32x4*)(so + 4) = zm2[1]; *(f32x4*)(so + LW) = zm1[0]; *(f32x4*)(so + LW + 4) = zm1[1];
        float* lo = smp ? args.out + O_SLC + ((size_t)l * DBATCH + b) * 3 * LW + c0 : args.out + O_PLC + ((size_t)l * NBATCH + b) * 3 * LW + c0;
#pragma unroll
        for (int k = 0; k < 3; ++k) { f32x4 x0, x1; unpack8(*(const u32x4*)(PROJ + (size_t)(row0 + 5 + k) * INC + C_LX + c0), x0, x1); *(f32x4*)(lo + k * LW) = x0; *(f32x4*)(lo + k * LW + 4) = x1; }
    }
}

__device__ __forceinline__ int crow(int r, int hi) { return (r & 3) + 8 * (r >> 2) + 4 * hi; }
constexpr int ATT_LDS = 8192;
__device__ __forceinline__ void attn_wg_unit(const Args& args, int l, int u, LAS unsigned char* lds, int tid_in) {
    int tid = tid_in; asm volatile("" : "+v"(tid));
    unsigned char* ws = args.ws;
    const bf16_t* PROJ = (const bf16_t*)(ws + WS_PROJ); bf16_t* AMEM = (bf16_t*)(ws + WS_ABR + 2 * SZ_ABR1);
    const int lane = tid & 63, wave = __builtin_amdgcn_readfirstlane(tid >> 6), r32 = lane & 31, hh = lane >> 5;
    const int panel = u >> 2, head = u & 3, b = panel >> 5, row0 = panel * 256 + 32 * wave;
    const bf16_t* Kb = (const bf16_t*)(ws + WS_KP) + (size_t)(l * NBATCH + b) * MEMLEN * MW + head * MHD;
    const bf16_t* Vt = (const bf16_t*)(ws + WS_VTP) + (size_t)((l * NBATCH + b) * MHEADS + head) * MHD * MEMLEN;
    LAS unsigned char* buf = lds + ATT_LDS;
    const int kkey = tid & 15, kdch = tid >> 4;
    const bf16_t* ksrc = Kb + (size_t)kkey * MW + 8 * kdch;
    const int kdst = (kdch >> 1) * 1024 + (kkey + 32 * (kdch & 1)) * 16;
    const int vd = tid >> 1, vs = tid & 1;
    const bf16_t* vsrc = Vt + (size_t)vd * MEMLEN + 16 * vs;
    const int vdst = ((vd >> 5) * 2 + vs) * 1024 + (vd & 31) * 16;
    bf16x8 qf[16];
    { const bf16_t* qp = PROJ + (size_t)(row0 + r32) * INC + C_Q + head * MHD + 8 * hh;
#pragma unroll
      for (int ks = 0; ks < 16; ++ks) qf[ks] = *(const bf16x8*)(qp + 16 * ks); }
    u32x4 s0, s1;
    s0 = *(const u32x4*)(ksrc); s1 = *(const u32x4*)(ksrc + (size_t)16 * MW);
    *(LAS u32x4*)(buf + kdst) = s0; *(LAS u32x4*)(buf + kdst + 256) = s1;
    __syncthreads();
    f32x16 st[8];
#pragma unroll
    for (int kt = 0; kt < 8; ++kt) {
        if (kt < 7) { s0 = *(const u32x4*)(ksrc + (size_t)(32 * (kt + 1)) * MW); s1 = *(const u32x4*)(ksrc + (size_t)(32 * (kt + 1) + 16) * MW); }
        else { s0 = *(const u32x4*)(vsrc); s1 = *(const u32x4*)(vsrc + 8); }
        const LAS unsigned char* cb = buf + (kt & 1) * 16384 + lane * 16;
        f32x16 acc;
#pragma unroll
        for (int i = 0; i < 16; ++i) acc[i] = 0.f;
#pragma unroll
        for (int ks = 0; ks < 16; ++ks) { const bf16x8 kf = *(const LAS bf16x8*)(cb + ks * 1024); acc = __builtin_amdgcn_mfma_f32_32x32x16_bf16(kf, qf[ks], acc, 0, 0, 0); }
        st[kt] = acc;
        LAS unsigned char* nb = buf + ((kt + 1) & 1) * 16384;
        if (kt < 7) { *(LAS u32x4*)(nb + kdst) = s0; *(LAS u32x4*)(nb + kdst + 256) = s1; }
        else { *(LAS u32x4*)(nb + vdst) = (u32x4){s0.x, s0.y, s1.x, s1.y}; *(LAS u32x4*)(nb + vdst + 512) = (u32x4){s0.z, s0.w, s1.z, s1.w}; }
        __syncthreads();
    }
    float mx = st[0][0];
#pragma unroll
    for (int kt = 0; kt < 8; ++kt)
#pragma unroll
        for (int i = 0; i < 16; ++i) mx = fmaxf(mx, st[kt][i]);
    mx = fmaxf(mx, __shfl_xor(mx, 32));
    float sum = 0.f;
    bf16x8 pf[8][2];
#pragma unroll
    for (int kt = 0; kt < 8; ++kt) {
#pragma unroll
        for (int i = 0; i < 16; ++i) { const float e = __builtin_amdgcn_exp2f(st[kt][i] - mx); st[kt][i] = e; sum += e; }
#pragma unroll
        for (int s = 0; s < 2; ++s) { u32x4 w; w.x = cvtpk(st[kt][8 * s + 0], st[kt][8 * s + 1]); w.y = cvtpk(st[kt][8 * s + 2], st[kt][8 * s + 3]); w.z = cvtpk(st[kt][8 * s + 4], st[kt][8 * s + 5]); w.w = cvtpk(st[kt][8 * s + 6], st[kt][8 * s + 7]);
            pf[kt][s] = __builtin_bit_cast(bf16x8, w); }
    }
    sum += __shfl_xor(sum, 32);
    const float inv = __builtin_amdgcn_rcpf(sum);
    f32x16 ot[8];
#pragma unroll
    for (int dt = 0; dt < 8; ++dt)
#pragma unroll
        for (int i = 0; i < 16; ++i) ot[dt][i] = 0.f;
#pragma unroll
    for (int kt = 0; kt < 8; ++kt) {
        if (kt < 7) { s0 = *(const u32x4*)(vsrc + 32 * (kt + 1)); s1 = *(const u32x4*)(vsrc + 32 * (kt + 1) + 8); }
        const LAS unsigned char* cb = buf + (kt & 1) * 16384 + lane * 16;
#pragma unroll
        for (int dt = 0; dt < 8; ++dt)
#pragma unroll
            for (int s = 0; s < 2; ++s) { const bf16x8 vf = *(const LAS bf16x8*)(cb + (dt * 2 + s) * 1024); ot[dt] = __builtin_amdgcn_mfma_f32_32x32x16_bf16(vf, pf[kt][s], ot[dt], 0, 0, 0); }
        if (kt < 7) {
            LAS unsigned char* nb = buf + ((kt + 1) & 1) * 16384;
            *(LAS u32x4*)(nb + vdst) = (u32x4){s0.x, s0.y, s1.x, s1.y}; *(LAS u32x4*)(nb + vdst + 512) = (u32x4){s0.z, s0.w, s1.z, s1.w};
        }
        __syncthreads();
    }
    bf16_t* op = AMEM + (size_t)(row0 + r32) * MW + head * MHD;
#pragma unroll
    for (int dt = 0; dt < 8; ++dt)
#pragma unroll
        for (int ig = 0; ig < 4; ++ig) {
            u32x2 w; w.x = cvtpk(ot[dt][4 * ig] * inv, ot[dt][4 * ig + 1] * inv); w.y = cvtpk(ot[dt][4 * ig + 2] * inv, ot[dt][4 * ig + 3] * inv);
            *(u32x2*)(op + 32 * dt + 8 * ig + 4 * hh) = w;
        }
}

__device__ __forceinline__ void attn_sample_unit(const Args& args, int l, int u, LAS unsigned char* lds, int tid_in) {
    int tid = tid_in; asm volatile("" : "+v"(tid));
    unsigned char* ws = args.ws;
    const bf16_t* PROJ = (const bf16_t*)(ws + WS_PROJ); bf16_t* AMEM = (bf16_t*)(ws + WS_ABR + 2 * SZ_ABR1);
    const int lane = tid & 63, wave = __builtin_amdgcn_readfirstlane(tid >> 6), r32 = lane & 31, hh = lane >> 5;
    const int head = u >> 5, b = u & 31, row0 = MP + b * DSEQ;
    const float* Kc = args.in[I_CK] + (size_t)(l * DBATCH + b) * MEMLEN * MW + head * MHD;
    const float* Vc = args.in[I_CV] + (size_t)(l * DBATCH + b) * MEMLEN * MW + head * MHD;
    LAS float* RMX = (LAS float*)(lds + ATT_LDS); LAS float* RSM = RMX + 256; LAS unsigned char* PB = lds + ATT_LDS + 4096;
    bf16x8 qf[16], kf[16];
    { const bf16_t* qp = PROJ + (size_t)(row0 + r32) * INC + C_Q + head * MHD + 8 * hh; const float* kp = Kc + (size_t)(32 * wave + r32) * MW + 8 * hh;
#pragma unroll
      for (int ks = 0; ks < 16; ++ks) { qf[ks] = *(const bf16x8*)(qp + 16 * ks); kf[ks] = __builtin_bit_cast(bf16x8, pack8(*(const f32x4*)(kp + 16 * ks), *(const f32x4*)(kp + 16 * ks + 4))); } }
    f32x16 acc;
#pragma unroll
    for (int i = 0; i < 16; ++i) acc[i] = 0.f;
#pragma unroll
    for (int ks = 0; ks < 16; ++ks) acc = __builtin_amdgcn_mfma_f32_32x32x16_bf16(kf[ks], qf[ks], acc, 0, 0, 0);
    float m = acc[0];
#pragma unroll
    for (int i = 1; i < 16; ++i) m = fmaxf(m, acc[i]);
    m = fmaxf(m, __shfl_xor(m, 32));
    if (hh == 0) RMX[wave * 32 + r32] = m;
    __syncthreads();
    float gm = RMX[r32];
#pragma unroll
    for (int w = 1; w < 8; ++w) gm = fmaxf(gm, RMX[w * 32 + r32]);
    float sm = 0.f;
#pragma unroll
    for (int i = 0; i < 16; ++i) { acc[i] = __builtin_amdgcn_exp2f(acc[i] - gm); sm += acc[i]; }
    sm += __shfl_xor(sm, 32);
    if (hh == 0) RSM[wave * 32 + r32] = sm;
#pragma unroll
    for (int s = 0; s < 2; ++s) { u32x4 w; w.x = cvtpk(acc[8 * s + 0], acc[8 * s + 1]); w.y = cvtpk(acc[8 * s + 2], acc[8 * s + 3]); w.z = cvtpk(acc[8 * s + 4], acc[8 * s + 5]); w.w = cvtpk(acc[8 * s + 6], acc[8 * s + 7]);
        *(LAS u32x4*)(PB + (wave * 2 + s) * 1024 + lane * 16) = w; }
    __syncthreads();
    float tot = 0.f;
#pragma unroll
    for (int w = 0; w < 8; ++w) tot += RSM[w * 32 + r32];
    const float inv = __builtin_amdgcn_rcpf(tot);
    f32x16 o;
#pragma unroll
    for (int i = 0; i < 16; ++i) o[i] = 0.f;
#pragma unroll
    for (int c = 0; c < 16; ++c) {
        const float* vp = Vc + (size_t)(16 * c + 4 * hh) * MW + 32 * wave + r32;
        u32x4 vw; vw.x = cvtpk(vp[0], vp[MW]); vw.y = cvtpk(vp[2 * MW], vp[3 * MW]); vw.z = cvtpk(vp[8 * MW], vp[9 * MW]); vw.w = cvtpk(vp[10 * MW], vp[11 * MW]);
        const bf16x8 vf = __builtin_bit_cast(bf16x8, vw);
        const bf16x8 pfr = *(const LAS bf16x8*)(PB + c * 1024 + lane * 16);
        o = __builtin_amdgcn_mfma_f32_32x32x16_bf16(vf, pfr, o, 0, 0, 0);
    }
    bf16_t* op = AMEM + (size_t)(row0 + r32) * MW + head * MHD + 32 * wave;
#pragma unroll
    for (int ig = 0; ig < 4; ++ig) {
        u32x2 w; w.x = cvtpk(o[4 * ig] * inv, o[4 * ig + 1] * inv); w.y = cvtpk(o[4 * ig + 2] * inv, o[4 * ig + 3] * inv);
        *(u32x2*)(op + 8 * ig + 4 * hh) = w;
    }
    __syncthreads();
}

template <int NR>
__device__ __forceinline__ void norm_prompt_rows(const Args& args, const float* gpost, bool last, bool want_q, const int (&rows)[NR], int lane) {
    unsigned char* ws = args.ws;
    const bf16_t* Y = (const bf16_t*)(ws + WS_Y); const float* SSY = (const float*)(ws + WS_SSY); bf16_t* XB = (bf16_t*)(ws + WS_XB); float* RS = (float*)(ws + WS_SSX);
    float part[NR], xs[NR], rstd[NR], ss[NR]; u32x4 xq[NR][4], yq[NR][4];
#pragma unroll
    for (int r = 0; r < NR; ++r) {
        part[r] = lane < 32 ? SSY[(size_t)rows[r] * 32 + lane] : 0.f; xs[r] = RS[rows[r]];
#pragma unroll
        for (int j = 0; j < 4; ++j) { xq[r][j] = *(const u32x4*)(XB + (size_t)rows[r] * DM + j * 512 + lane * 8); yq[r][j] = *(const u32x4*)(Y + (size_t)rows[r] * DM + j * 512 + lane * 8); }
    }
#pragma unroll
    for (int o = 1; o < 64; o <<= 1)
#pragma unroll
        for (int r = 0; r < NR; ++r) part[r] += __shfl_xor(part[r], o);
#pragma unroll
    for (int r = 0; r < NR; ++r) { rstd[r] = __builtin_amdgcn_rsqf(part[r] * (1.0f / DM) + EPS); ss[r] = 0.f; }
    f32x4 n0[NR][4], n1[NR][4];
#pragma unroll
    for (int j = 0; j < 4; ++j) {
        const int c = j * 512 + lane * 8;
        const f32x4 g0 = *(const f32x4*)(gpost + c), g1 = *(const f32x4*)(gpost + c + 4);
#pragma unroll
        for (int r = 0; r < NR; ++r) {
            f32x4 x0, x1, y0, y1; unpack8(xq[r][j], x0, x1); unpack8(yq[r][j], y0, y1);
            const f32x4 a = x0 * xs[r] + y0 * rstd[r] * g0, b = x1 * xs[r] + y1 * rstd[r] * g1;
            n0[r][j] = a; n1[r][j] = b;
            ss[r] += (a[0] * a[0] + a[1] * a[1]) + (a[2] * a[2] + a[3] * a[3]) + (b[0] * b[0] + b[1] * b[1]) + (b[2] * b[2] + b[3] * b[3]);
        }
    }
    if (last) {
#pragma unroll
        for (int r = 0; r < NR; ++r) { float* xo = args.out + (size_t)rows[r] * DM;
#pragma unroll
            for (int j = 0; j < 4; ++j) { *(f32x4*)(xo + j * 512 + lane * 8) = n0[r][j]; *(f32x4*)(xo + j * 512 + lane * 8 + 4) = n1[r][j]; } }
    } else {
#pragma unroll
        for (int o = 1; o < 64; o <<= 1)
#pragma unroll
            for (int r = 0; r < NR; ++r) ss[r] += __shfl_xor(ss[r], o);
#pragma unroll
        for (int r = 0; r < NR; ++r) {
            const float ms = ss[r] * (1.0f / DM) + EPS, rs2 = __builtin_amdgcn_rsqf(ms);
#pragma unroll
            for (int j = 0; j < 4; ++j) *(u32x4*)(XB + (size_t)rows[r] * DM + j * 512 + lane * 8) = pack8(n0[r][j] * rs2, n1[r][j] * rs2);
            if (lane == 0) RS[rows[r]] = __builtin_sqrtf(ms);
            if (want_q) row_quant8(n0[r], n1[r], rs2, ws + WS_XQ + (size_t)rows[r] * DM, (float*)(ws + WS_SA) + rows[r], lane);
        }
    }
}
__device__ __forceinline__ void norm_rows(const Args& args, const float* gpost, const float* yp, bool ybf, bool last, bool want_q, int gw, int ngw, int lane) {
    asm volatile("" : "+v"(lane)); asm volatile("" : "+s"(gw));
    unsigned char* ws = args.ws;
    bf16_t* XB = (bf16_t*)(ws + WS_XB); float* RS = (float*)(ws + WS_SSX);
    int row = gw;
    for (; row + ngw < MP; row += 2 * ngw) { const int rows[2] = {row, row + ngw}; norm_prompt_rows<2>(args, gpost, last, want_q, rows, lane); }
    for (; row < MP; row += ngw) { const int rows[1] = {row}; norm_prompt_rows<1>(args, gpost, last, want_q, rows, lane); }
    for (; row < MT; row += ngw) {
        f32x4 ya[4], yb[4];
        const float xs = RS[row];
        u32x4 xq[4];
#pragma unroll
        for (int j = 0; j < 4; ++j) xq[j] = *(const u32x4*)(XB + (size_t)row * DM + j * 512 + lane * 8);
        float sq = 0.f;
#pragma unroll
        for (int j = 0; j < 4; ++j) {
            f32x4 a, b;
            if (ybf) {
                const bf16_t* pp = (const bf16_t*)yp + (size_t)(row - MP) * DM + j * 512 + lane * 8;
                u32x4 pv[8];
#pragma unroll
                for (int s = 0; s < 8; ++s) pv[s] = *(const u32x4*)(pp + (size_t)s * MS * DM);
                unpack8(pv[0], a, b);
#pragma unroll
                for (int s = 1; s < 8; ++s) { f32x4 a2, b2; unpack8(pv[s], a2, b2); a += a2; b += b2; }
            } else {
                const float* pp = yp + (size_t)(row - MP) * DM + j * 512 + lane * 8;
                a = *(const f32x4*)pp; b = *(const f32x4*)(pp + 4);
#pragma unroll
                for (int s = 1; s < 8; ++s) { a += *(const f32x4*)(pp + (size_t)s * MS * DM); b += *(const f32x4*)(pp + (size_t)s * MS * DM + 4); }
            }
            ya[j] = a; yb[j] = b;
            sq += (a[0] * a[0] + a[1] * a[1]) + (a[2] * a[2] + a[3] * a[3]) + (b[0] * b[0] + b[1] * b[1]) + (b[2] * b[2] + b[3] * b[3]);
        }
        const float rstd = __builtin_amdgcn_rsqf(wave_sum(sq) * (1.0f / DM) + EPS);
        float ss = 0.f; f32x4 n0[4], n1[4];
#pragma unroll
        for (int j = 0; j < 4; ++j) {
            const int c = j * 512 + lane * 8;
            f32x4 x0, x1; unpack8(xq[j], x0, x1);
            const f32x4 g0 = *(const f32x4*)(gpost + c), g1 = *(const f32x4*)(gpost + c + 4);
            n0[j] = x0 * xs + ya[j] * rstd * g0; n1[j] = x1 * xs + yb[j] * rstd * g1;
            ss += (n0[j][0] * n0[j][0] + n0[j][1] * n0[j][1]) + (n0[j][2] * n0[j][2] + n0[j][3] * n0[j][3]) + (n1[j][0] * n1[j][0] + n1[j][1] * n1[j][1]) + (n1[j][2] * n1[j][2] + n1[j][3] * n1[j][3]);
        }
        if (last) {
            float* xo = args.out + (size_t)row * DM;
#pragma unroll
            for (int j = 0; j < 4; ++j) { *(f32x4*)(xo + j * 512 + lane * 8) = n0[j]; *(f32x4*)(xo + j * 512 + lane * 8 + 4) = n1[j]; }
        } else {
            const float ms = wave_sum(ss) * (1.0f / DM) + EPS, rs2 = __builtin_amdgcn_rsqf(ms);
#pragma unroll
            for (int j = 0; j < 4; ++j) *(u32x4*)(XB + (size_t)row * DM + j * 512 + lane * 8) = pack8(n0[j] * rs2, n1[j] * rs2);
            if (lane == 0) RS[row] = __builtin_sqrtf(ms);
            if (want_q) row_quant8(n0, n1, rs2, ws + WS_XQ + (size_t)row * DM, (float*)(ws + WS_SA) + row, lane);
        }
    }
}

__global__ void __launch_bounds__(512, 2) mk_fwd(Args args) {
    extern __shared__ __attribute__((aligned(16))) unsigned char lds_raw[];
    LAS unsigned char* lds = (LAS unsigned char*)lds_raw;
    volatile LAS unsigned* MISC = (volatile LAS unsigned*)(lds + MISC_OFF);
    const int tid = threadIdx.x, lane = tid & 63, wave = __builtin_amdgcn_readfirstlane(tid >> 6);
    const int G = gridDim.x, bx = blockIdx.x;
    const int vcu = (G % 8 == 0) ? (bx % 8) * (G / 8) + bx / 8 : bx;
    const int gw = vcu * 8 + wave, ngw = G * 8;
    unsigned char* ws = args.ws;
    if (tid < 64) MISC[tid] = 0u;
    __syncthreads();
    XcdBarrier bar; bar.bar = (unsigned*)(ws + WS_CTL) + 4096; bar.x = 0; bar.st = MISC + 8;
    if (!MK_MULTI) bar = xcd_barrier_post((unsigned*)(ws + WS_CTL) + 4096, MISC + 8);
    const int lo = args.ph_lo, hi = args.ph_hi;
#define IN(k) (lo <= (k) && (k) < hi)
#define SEAM(k) do { if (IN(k) && IN((k) + 1)) for (int rr = 0; rr < DUP_BAR; ++rr) xcd_barrier(bar); } while (0)

    if (IN(0)) for (int rr = 0; rr < DUP_PRO; ++rr) {
        LAS float* scr = (LAS float*)(lds + wave * 16384);
        for (int t = gw; t < DEPTH * 60 * 16; t += ngw) {
            const int lr = t / (60 * 16), l = DEPTH - 1 - lr, r_ = t - lr * (60 * 16), strip = r_ >> 4, kb = r_ & 15;
            const bool up = strip >= 28; const int c0 = (up ? strip - 28 : strip) * 256 + 4 * lane, pitch = up ? DFF : INC;
            const float* wp = (up ? args.in[I_WUP] + (size_t)l * DM * DFF : args.in[I_WIN] + (size_t)l * DM * INC + C_I8) + (size_t)(kb * 128) * pitch + c0;
            const float* gp = (up ? args.in[I_GMLPPRE] : args.in[I_GMIXPRE]) + l * DM + kb * 128;
            f32x4 m = (f32x4){0.f, 0.f, 0.f, 0.f};
#pragma unroll 16
            for (int k = 0; k < 128; ++k) { const f32x4 v = *(const f32x4*)(wp + (size_t)k * pitch); const float g_ = __builtin_fabsf(gp[k]);
                m[0] = fmaxf(m[0], __builtin_fabsf(v[0]) * g_); m[1] = fmaxf(m[1], __builtin_fabsf(v[1]) * g_); m[2] = fmaxf(m[2], __builtin_fabsf(v[2]) * g_); m[3] = fmaxf(m[3], __builtin_fabsf(v[3]) * g_); }
            unsigned* cm = (unsigned*)(ws + WS_CTL) + CW_CMAX + l * CM_L + (up ? NI8 : 0) + c0;
#pragma unroll
            for (int e = 0; e < 4; ++e) atomicMax(cm + e, __float_as_uint(m[e]));
        }
        for (int t = gw; t < DEPTH * 8 * 64; t += ngw) {
            const int l = DEPTH - 1 - (t >> 9), r_ = t & 511, strip = r_ >> 6, kb = r_ & 63, c0 = strip * 256 + 4 * lane;
            const float* wp = args.in[I_WDN] + (size_t)l * DFF * DM + (size_t)(kb * 128) * DM + c0;
            f32x4 m = (f32x4){0.f, 0.f, 0.f, 0.f};
#pragma unroll 16
            for (int k = 0; k < 128; ++k) { const f32x4 v = *(const f32x4*)(wp + (size_t)k * DM);
                m[0] = fmaxf(m[0], __builtin_fabsf(v[0])); m[1] = fmaxf(m[1], __builtin_fabsf(v[1])); m[2] = fmaxf(m[2], __builtin_fabsf(v[2])); m[3] = fmaxf(m[3], __builtin_fabsf(v[3])); }
            unsigned* cm = (unsigned*)(ws + WS_CTL) + CW_CMAX + l * CM_L + NI8 + DFF + c0;
#pragma unroll
            for (int e = 0; e < 4; ++e) atomicMax(cm + e, __float_as_uint(m[e]));
        }
        if (!MK_MULTI) xcd_barrier(bar);
        conv_stream<true>(args, scr, lane, 0, IT_LW + (IT_ALL - IT_W), gw, ngw, IT_LW, IT_W - IT_LW);
        { float* c8t = (float*)(ws + WS_PA); const float* lam = args.in[I_LAM];
          for (int i = gw * 64 + lane; i < DEPTH * LW; i += ngw * 64) c8t[i] = 8.0f * log1pf(__expf(-lam[i])); }
        { bf16_t* wat = (bf16_t*)(ws + WS_WAT); bf16_t* wit = (bf16_t*)(ws + WS_WIT); const float* wa = args.in[I_LWA]; const float* wi = args.in[I_LWI];
          for (int i = gw * 64 + lane; i < DEPTH * LHEADS * 64 * 64; i += ngw * 64) { const int hh = i >> 12, jj = (i >> 6) & 63, ii = i & 63; wat[i] = f2bf(wa[(hh * 64 + ii) * 64 + jj]); wit[i] = f2bf(wi[(hh * 64 + ii) * 64 + jj]); } }
        { bf16_t* sl = (bf16_t*)(ws + WS_SLCB); const float* s = args.in[I_SLC]; const int n8 = DEPTH * DBATCH * 3 * LW / 8;
          for (int i = gw * 64 + lane; i < n8; i += ngw * 64) { const f32x4 a = *(const f32x4*)(s + (size_t)i * 8), b = *(const f32x4*)(s + (size_t)i * 8 + 4); *(u32x4*)(sl + (size_t)i * 8) = pack8(a, b); } }
        { bf16_t* XB = (bf16_t*)(ws + WS_XB);
          for (int row = gw; row < MT; row += ngw) { const float* xr = row < MP ? args.in[I_XP] + (size_t)row * DM : args.in[I_XS] + (size_t)(row - MP) * DM; const float sc = row_to_bf16_normed(xr, XB + (size_t)row * DM, lane, ws + WS_XQ + (size_t)row * DM, (float*)(ws + WS_SA) + row); if (lane == 0) ((float*)(ws + WS_SSX))[row] = sc; } }
        { bf16_t* MB = (bf16_t*)(ws + WS_MEMB);
          for (int row = gw; row < NBATCH * MEMLEN; row += ngw) row_to_bf16_normed(args.in[I_MEM] + (size_t)row * DM, MB + (size_t)row * DM, lane); }
        __syncthreads();
    }
    SEAM(0);

    for (int l = 0; l < DEPTH; ++l) {
        const int pb = 1 + 9 * l;
        if (IN(pb + 0)) {
#ifndef NO_KV
            if (l == 0) {
                pg8::Gemm g{(const char*)(ws + WS_MEMB), (const char*)(ws + WS_WKV), DM, DM, DM, 0, 0};
                pg8::KvOrder S{bx};
                pg8::EpiKV E{args.out + O_PMK, args.out + O_PMV, (bf16_t*)(ws + WS_KP), (bf16_t*)(ws + WS_VTP)};
                pg8::gemm_phase<pg8::EpiKV, pg8::KvOrder>(lds, g, S, E);
            }
#endif

#ifndef NO_GIN
            {
                pg8::Gemm g{(const char*)(ws + WS_XB), (const char*)(ws + WS_WIN + l * SZ_WIN), DM, DM, DM, 0, 0};
                pg8::StaticOrder S; S.init(MT, C_I8, G, bx); S.ntk = DM / 64;
                pg8::EpiIn E{(bf16_t*)(ws + WS_PROJ), args.in[I_BGATE] + (size_t)l * 3 * DM};
                for (int rr = 0; rr < DUP_GIN; ++rr) pg8::gemm_phase<pg8::EpiIn, pg8::StaticOrder>(lds, g, S, E);
            }
            {
                pg8::Gemm g{(const char*)(ws + WS_XQ), (const char*)(ws + WS_WIN + l * SZ_WIN + WQ_OFF), DM / 2, DM / 2, DM / 2, 0, 0};
                pg8::StaticOrder S; S.init(MT, NI8, G, G - 1 - bx); S.ntk = DM / 128;
                pg8::EpiIn8 E{(bf16_t*)(ws + WS_PROJ), args.in[I_BGATE] + (size_t)l * 3 * DM, (const float*)(ws + WS_SA), (const unsigned*)(ws + WS_CTL) + CW_CMAX + l * CM_L, ws + WS_G8};
                pg8::gemm_phase<pg8::EpiIn8, pg8::StaticOrder, true>(lds, g, S, E);
            }
#endif
        }
        SEAM(pb + 0);
        if (IN(pb + 2)) for (int rep = 0; rep < DUP_THIN; ++rep) {
            if (rep) __syncthreads();
#ifndef NO_LRUF
            for (int rr = 0; rr < DUP_LRU; ++rr)
            for (int u = vcu; u < 64 * LHEADS; u += G) lru_unit<true, false>(args, l, u >> 4, u & 15, lds, wave, lane);
            for (int u = 64 * LHEADS + vcu; u < NPANEL * LHEADS; u += G) lru_unit<true, true>(args, l, u >> 4, u & 15, lds, wave, lane);
#endif
#ifndef NO_ATTN
            for (int u = vcu; u < 256; u += G) attn_wg_unit(args, l, u, lds, tid);
            if (G == 256) {
                if (vcu >= 128) attn_sample_unit(args, l, vcu - 128, lds, tid);
#ifndef NO_SCONV
                if (vcu >= 64) for (int it = (vcu - 64) * 8 + wave; it < (MT / 8) * 2; it += 192 * 8) sconv_item(args, l, it, lane);
#endif
            } else {
                for (int u = vcu; u < 128; u += G) attn_sample_unit(args, l, u, lds, tid);
#ifndef NO_SCONV
                for (int it = gw; it < (MT / 8) * 2; it += ngw) sconv_item(args, l, it, lane);
#endif
            }
#endif
        }
        SEAM(pb + 2);
        if (IN(pb + 3)) {
#ifndef NO_GBR
            pg8::Gemm g{(const char*)(ws + WS_ABR), (const char*)(ws + WS_WBR + (size_t)l * 3 * SZ_WBR1), 1024, 1024, 1024, SZ_ABR1, SZ_WBR1};
            pg8::Seg3Order S; S.init(MP, DM, G, bx); S.ntk = 1024 / 64;
            pg8::EpiBranch E{(const unsigned char*)(ws + WS_G8), (bf16_t*)(ws + WS_MERGED)};
            for (int rr = 0; rr < DUP_GBR; ++rr) pg8::gemm_phase<pg8::EpiBranch, pg8::Seg3Order>(lds, g, S, E);
            pg8::SegSubOrder S2{bx}; pg8::EpiPart E2{(float*)(ws + WS_BP)};
            pg8::gemm_phase<pg8::EpiPart, pg8::SegSubOrder>(lds, g, S2, E2);
            if (l + 1 < DEPTH && G == 256 && bx >= 96)
                conv_stream<false>(args, (LAS float*)(lds + wave * 16384), lane, (l + 1) * IT_LW, (l + 1) * IT_LW + CV_B, (bx - 96) * 8 + wave, 160 * 8);
#endif

        }
        SEAM(pb + 3);
        if (IN(pb + 4)) {
            {
                const float* bp = (const float*)(ws + WS_BP); const bf16_t* PROJ = (const bf16_t*)(ws + WS_PROJ); bf16_t* Mg = (bf16_t*)(ws + WS_MERGED);
                int ln = lane; asm volatile("" : "+v"(ln));
                for (int i = gw * 64 + ln; i < MS * DM / 8; i += ngw * 64) {
                    const int r = i >> 8, c = (i & 255) * 8;
                    f32x4 o0 = (f32x4){0.f, 0.f, 0.f, 0.f}, o1 = o0;
#pragma unroll
                    for (int s = 0; s < 3; ++s) {
                        const float* pp = bp + ((size_t)s * MS + r) * DM + c; f32x4 g0, g1; pg8::unpack8u(*(const u32x2*)(ws + WS_G8 + pg8::g8_tile(64 + (r >> 8), s * 8 + (c >> 8)) + ((((r >> 6) & 1) * 4 + ((c >> 6) & 3)) * 16 + (((r >> 7) & 1) * 4 + ((r >> 4) & 3)) * 2 + ((c >> 5) & 1)) * 512 + (((c >> 3) & 3) * 16 + (r & 15)) * 8), g0, g1); g0 = g0 * (1.0f / 255.0f); g1 = g1 * (1.0f / 255.0f);
                        o0 += g0 * *(const f32x4*)pp; o1 += g1 * *(const f32x4*)(pp + 4);
                    }
                    *(u32x4*)(Mg + (size_t)(MP + r) * DM + c) = pack8(o0, o1);
                }
                if (!MK_MULTI) xcd_barrier(bar);
            }
#ifndef NO_GOUT
            pg8::Gemm g{(const char*)(ws + WS_MERGED), (const char*)(ws + WS_WOUT + l * SZ_WOUT), DM, DM, DM, 0, 0};
            pg8::SplitOrder S; S.init(MP, DM, G, bx); S.ntk = DM / 64;
            pg8::EpiY E{(bf16_t*)(ws + WS_Y), (float*)(ws + WS_SSY), (float*)(ws + WS_PROJ)};
            for (int rr = 0; rr < DUP_GOUT; ++rr) pg8::gemm_phase<pg8::EpiY, pg8::SplitOrder>(lds, g, S, E);
#endif

        }
        SEAM(pb + 4);
        if (IN(pb + 5)) norm_rows(args, args.in[I_GMIXPOST] + (size_t)l * DM, (const float*)(ws + WS_PROJ), true, false, true, gw, ngw, lane);
        SEAM(pb + 5);
        if (IN(pb + 6)) {
#ifndef NO_GUP
            pg8::Gemm g{(const char*)(ws + WS_XQ), (const char*)(ws + WS_WUP + l * SZ_WUP), DM / 2, DM / 2, DM / 2, 0, 0};
            pg8::UpOrder S{bx, G, DM / 128};
            for (int rr = 0; rr < DUP_GUP; ++rr) {
            pg8::EpiUp8 E{ws, l, l * DUP_GUP + rr + 1};
            pg8::gemm_phase<pg8::EpiUp8, pg8::UpOrder, true>(lds, g, S, E); }
            if (l + 1 < DEPTH && G == 256 && bx >= 128)
                conv_stream<false>(args, (LAS float*)(lds + wave * 16384), lane, (l + 1) * IT_LW + CV_B, (l + 2) * IT_LW, (bx - 128) * 8 + wave, 128 * 8);
#endif

        }
        SEAM(pb + 6);
        if (IN(pb + 7)) {
#ifndef NO_GDN
            pg8::Gemm g{(const char*)(ws + WS_PROJ), (const char*)(ws + WS_WDN + l * SZ_WUP), DFF / 2, DFF / 2, DFF / 2, 0, 0};
            pg8::SplitOrder S; S.init(MP, DM, G, bx); S.ntk = DFF / 128;
            pg8::EpiY8 E{(bf16_t*)(ws + WS_Y), (float*)(ws + WS_SSY), (float*)(ws + WS_MERGED), (const unsigned*)(ws + WS_CTL) + CW_RMAX + l * MT,
                         (const unsigned*)(ws + WS_CTL) + CW_CMAX + l * CM_L + NI8 + DFF, (const int*)(ws + WS_CTL) + cw_csum9(l)};
            for (int rr = 0; rr < DUP_GDN; ++rr) pg8::gemm_phase<pg8::EpiY8, pg8::SplitOrder, true>(lds, g, S, E);
#endif

        }
        SEAM(pb + 7);
        if (IN(pb + 8)) norm_rows(args, args.in[I_GMLPPOST] + (size_t)l * DM, (const float*)(ws + WS_MERGED), true, l == DEPTH - 1, true, gw, ngw, lane);
        SEAM(pb + 8);
    }
#undef IN
#undef SEAM
}

extern "C" void kernel_launch(void* const* d_in, const int* in_sizes, int n_in, void* d_out, int out_size, void* d_ws, size_t ws_size, hipStream_t stream) {
    static int grid = 0;
    if (grid == 0) {
        if (n_in != 30 || out_size != (int)O_END || ws_size < WS_END) { fprintf(stderr, "kernel_launch: unexpected shapes (n_in %d, out %d, ws %zu < %zu)\n", n_in, out_size, ws_size, (size_t)WS_END); grid = -1; return; }
        int dev = 0, cus = 0, per_cu = 0;
        if (hipGetDevice(&dev) != hipSuccess || hipDeviceGetAttribute(&cus, hipDeviceAttributeMultiprocessorCount, dev) != hipSuccess) { grid = -1; return; }
        if (hipFuncSetAttribute((const void*)mk_fwd, hipFuncAttributeMaxDynamicSharedMemorySize, LDS_BYTES) != hipSuccess) { fprintf(stderr, "kernel_launch: hipFuncSetAttribute failed\n"); grid = -1; return; }
        if (hipOccupancyMaxActiveBlocksPerMultiprocessor(&per_cu, (const void*)mk_fwd, 512, LDS_BYTES) != hipSuccess || per_cu < 1) fprintf(stderr, "kernel_launch: occupancy query reports %d\n", per_cu);
        (void)hipGetLastError();
        grid = cus;
    }
    if (grid < 0) return;
    static_assert(WS_GRAN == 0 && WS_CTL == 1 * MiB, "the two zeroed regions are adjacent");
    if (hipMemsetAsync((char*)d_ws + WS_GRAN, 0, 1 * MiB + CTL_ZERO_BYTES, stream) != hipSuccess) return;
    Args a{};
    for (int i = 0; i < 30; ++i) a.in[i] = (const float*)d_in[i];
    a.out = (float*)d_out; a.ws = (unsigned char*)d_ws;
#if MK_MULTI
    for (int p = 0; p < NPH; ++p) { a.ph_lo = p; a.ph_hi = p + 1; hipLaunchKernelGGL(mk_fwd, dim3(grid), dim3(512), LDS_BYTES, stream, a); }
#else
    a.ph_lo = 0; a.ph_hi = NPH;
    hipLaunchKernelGGL(mk_fwd, dim3(grid), dim3(512), LDS_BYTES, stream, a);
#endif
}
```

```cpp
#include <hip/hip_runtime.h>
#include <cstdio>
#include <cstdint>

#define LAS __attribute__((address_space(3)))
#define GAS __attribute__((address_space(1)))
typedef unsigned short bf16_t;
typedef short bf16x8 __attribute__((ext_vector_type(8)));
typedef short s16x4 __attribute__((ext_vector_type(4)));
typedef float f32x4 __attribute__((ext_vector_type(4)));
typedef float f32x2 __attribute__((ext_vector_type(2)));
typedef float f32x16 __attribute__((ext_vector_type(16)));
typedef unsigned u32x4 __attribute__((ext_vector_type(4)));
typedef unsigned u32x2 __attribute__((ext_vector_type(2)));
typedef __bf16 bf16x2_t __attribute__((ext_vector_type(2)));

#ifndef DUP_THIN
#define DUP_THIN 1
#endif
#ifndef DUP_LRU
#define DUP_LRU 1
#endif
#ifndef DUP_ATT
#define DUP_ATT 1
#endif
#ifndef DUP_SC
#define DUP_SC 1
#endif
#ifndef DUP_NORM
#define DUP_NORM 1
#endif
#ifndef DUP_BAR
#define DUP_BAR 1
#endif
#ifndef DUP_PRO
#define DUP_PRO 1
#endif
#ifndef DUP_GIN
#define DUP_GIN 1
#endif
#ifndef DUP_GDN
#define DUP_GDN 1
#endif
#ifndef DUP_GUP
#define DUP_GUP 1
#endif
#ifndef DUP_GBR
#define DUP_GBR 1
#endif
#ifndef DUP_GOUT
#define DUP_GOUT 1
#endif
#ifndef PG8_SP2
#define PG8_SP2 1
#endif
#ifndef PG8_ALIGN
#define PG8_ALIGN 1
#endif
#ifndef MK_MULTI
#define MK_MULTI 0
#endif

constexpr int DM = 2048, NBATCH = 2, SEQ = 8192, DEPTH = 4, DBATCH = 32, DSEQ = 32;
constexpr int MP = NBATCH * SEQ, MS = DBATCH * DSEQ, MT = MP + MS;
constexpr int LW = 1024, LHEADS = 16, LHD = 64;
constexpr int MEMLEN = 256, MHEADS = 4, MHD = 256, MW = 1024;
constexpr int INC = 12288, DFF = 8192;
constexpr int NPANEL = MT / 256;
constexpr float EPS = 1e-6f;
constexpr float LOG2E = 1.4426950408889634f;
constexpr int C_LX = 0, C_LG = 1024, C_SB = 2048, C_SC = 3072, C_SH = 4096, C_Q = 5120, C_GT = 6144;
constexpr int C_I8 = 5120, NI8 = 12288 - C_I8;

constexpr size_t O_YP = 0, O_YS = (size_t)MP * DM, O_PLH = O_YS + (size_t)MS * DM, O_PLC = O_PLH + DEPTH * NBATCH * LW,
                 O_PSC = O_PLC + DEPTH * NBATCH * 3 * LW, O_PMK = O_PSC + DEPTH * NBATCH * 2 * LW, O_PMV = O_PMK + (size_t)DEPTH * NBATCH * MEMLEN * MW,
                 O_SLH = O_PMV + (size_t)DEPTH * NBATCH * MEMLEN * MW, O_SLC = O_SLH + DEPTH * DBATCH * LW, O_SSC = O_SLC + DEPTH * DBATCH * 3 * LW,
                 O_END = O_SSC + DEPTH * DBATCH * 2 * LW;
static_assert(O_END == 40681472, "output size");

constexpr size_t MiB = 1u << 20;
constexpr size_t WS_CTL = 1 * MiB, CTL_ZERO_BYTES = 1 * MiB;
constexpr size_t WS_SSX = 2 * MiB;
constexpr size_t WS_SSY = WS_SSX + 128 * 1024;
constexpr size_t WS_MRSTD = WS_SSY + (size_t)MT * 32 * 4;
constexpr size_t WS_PA = 5 * MiB, WS_PB = WS_PA + 256 * 1024;
constexpr size_t WS_SLCB = WS_PB + 256 * 1024;
constexpr size_t WS_WAT = WS_SLCB + 768 * 1024, WS_WIT = WS_WAT + 512 * 1024;
constexpr size_t WS_MEMB = WS_WIT + 512 * 1024;
static_assert(WS_MEMB + 2 * MiB <= 10 * MiB, "small buffers below the weights");
constexpr size_t WS_GRAN = 0;
constexpr size_t WS_WIN = 10 * MiB;
constexpr size_t SZ_WIN = (size_t)INC * DM * 2;
constexpr size_t WS_WBR = WS_WIN + 4 * SZ_WIN;
constexpr size_t SZ_WBR1 = (size_t)DM * 1024 * 2;
constexpr size_t WS_WOUT = WS_WBR + 12 * SZ_WBR1;
constexpr size_t SZ_WOUT = (size_t)DM * DM * 2;
constexpr size_t WS_WUP = WS_WOUT + 4 * SZ_WOUT;
constexpr size_t SZ_WUP = (size_t)DFF * DM * 2;
constexpr size_t WS_WDN = WS_WUP + 4 * SZ_WUP;
constexpr size_t WS_WKV = WS_WDN + 4 * SZ_WUP;
constexpr size_t WS_XB = WS_WKV + 4 * SZ_WOUT;
constexpr size_t SZ_ACT2K = (size_t)MT * DM * 2;
constexpr size_t WS_PROJ = WS_XB + SZ_ACT2K;
constexpr size_t WS_ABR = WS_PROJ + (size_t)MT * INC * 2;
constexpr size_t SZ_ABR1 = (size_t)MT * 1024 * 2;
constexpr size_t WS_MERGED = WS_ABR + 3 * SZ_ABR1;
constexpr size_t WS_Y = WS_MERGED + SZ_ACT2K;
constexpr size_t WS_KP = WS_Y + SZ_ACT2K;
constexpr size_t WS_VTP = WS_KP + 4 * MiB;
constexpr size_t WS_KS = WS_VTP + 4 * MiB;
constexpr size_t WS_VTS = WS_KS + 64 * MiB;
constexpr size_t WS_G8 = WS_KS;
static_assert((size_t)MT * 3 * DM <= 128 * MiB, "gate bytes fit the old cache-copy area");
constexpr size_t WS_BP = WS_VTS + 64 * MiB;
constexpr size_t WS_XQ = WS_BP + 24 * MiB;
constexpr size_t WS_END = WS_XQ + (size_t)MT * DM;
constexpr size_t WS_SA = WS_MRSTD + 4096;
constexpr size_t WQ_OFF = (size_t)C_I8 * DM * 2;
constexpr int CW_CMAX = 16384, CM_L = NI8 + DFF + DM;
constexpr int CW_RCNT = 8192, CW_CSUM = 98304, CW_RMAX = 131072;
static_assert(CW_CMAX + DEPTH * CM_L <= CW_CSUM && CW_CSUM + DEPTH * DM <= CW_RMAX && (CW_RMAX + DEPTH * MT) * 4 <= (int)CTL_ZERO_BYTES, "control words inside the memset region");
__host__ __device__ constexpr int cw_csum9(int l) { return l < 3 ? CW_RMAX + DEPTH * MT + l * 9 * DM : CW_CSUM + DEPTH * DM; }
static_assert((CW_RMAX + DEPTH * MT + 3 * 9 * DM) * 4 <= (int)CTL_ZERO_BYTES && CW_CSUM + DEPTH * DM + 9 * DM <= CW_RMAX, "slice sums inside the memset region");
static_assert((CW_CMAX + DEPTH * CM_L) * 4 <= (int)CTL_ZERO_BYTES, "column maxima inside the memset region");
static_assert(WS_SA + (size_t)MT * 4 <= WS_PA && WS_END <= (size_t)1536 * MiB, "d_ws map");

constexpr int RING_BYTES = 131072;
constexpr int MISC_OFF = RING_BYTES;
constexpr int LDS_BYTES = 147456;

__device__ __forceinline__ unsigned cvtpk(float lo, float hi) { f32x2 v = {lo, hi}; bf16x2_t b = __builtin_convertvector(v, bf16x2_t); return __builtin_bit_cast(unsigned, b); }
__device__ __forceinline__ u32x4 pack8(f32x4 a, f32x4 b) { u32x4 w; w.x = cvtpk(a[0], a[1]); w.y = cvtpk(a[2], a[3]); w.z = cvtpk(b[0], b[1]); w.w = cvtpk(b[2], b[3]); return w; }
__device__ __forceinline__ float bf_lo(unsigned w) { return __uint_as_float(w << 16); }
__device__ __forceinline__ float bf_hi(unsigned w) { return __uint_as_float(w & 0xffff0000u); }
__device__ __forceinline__ float bf1(bf16_t v) { return __uint_as_float(((unsigned)v) << 16); }
__device__ __forceinline__ void unpack8(u32x4 w, f32x4& a, f32x4& b) { a = (f32x4){bf_lo(w.x), bf_hi(w.x), bf_lo(w.y), bf_hi(w.y)}; b = (f32x4){bf_lo(w.z), bf_hi(w.z), bf_lo(w.w), bf_hi(w.w)}; }
__device__ __forceinline__ bf16_t f2bf(float f) { return (bf16_t)(cvtpk(f, 0.f) & 0xffffu); }
__device__ __forceinline__ float fsigmoid(float v) { return __builtin_amdgcn_rcpf(1.0f + __builtin_amdgcn_exp2f(-LOG2E * v)); }
__device__ __forceinline__ float fgelu_tanh(float v) { const float t = v + 0.044715f * v * v * v; return v * __builtin_amdgcn_rcpf(1.0f + __builtin_amdgcn_exp2f(-2.3022081985f * t)); }
__device__ __forceinline__ float wave_sum(float v) {
#pragma unroll
    for (int o = 1; o < 64; o <<= 1) v += __shfl_xor(v, o);
    return v;
}
#define LDS_WAIT() asm volatile("s_waitcnt lgkmcnt(0)" ::: "memory")
#define VM_WAIT() asm volatile("s_waitcnt vmcnt(0)" ::: "memory")

namespace pg8 {
constexpr int BM = 256, BK = 64, HALF = 128, HTB = HALF * BK * 2, STAGE_BYTES = 8 * HTB, NXCD = 8, WGM = 8;
__host__ __device__ __forceinline__ int lds_byte(int r, int c) { const int st = (r >> 4) * 2 + (c >> 5), rr = r & 15, cc = c & 31, ob = rr * 64 + cc * 2; return st * 1024 + (ob ^ (((ob >> 9) & 1) << 5)); }
__host__ __device__ __forceinline__ void stage_rc(int b, int& R, int& C) { const int st = b / 1024, sb = b % 1024, swz = sb ^ (((sb >> 9) & 1) << 5); R = (st >> 1) * 16 + swz / 64; C = (st & 1) * 32 + (swz % 64) / 2; }
__host__ __device__ __forceinline__ int perm32(int rho) { const int n = rho >> 4, i = rho & 15; return 8 * (i >> 2) + 4 * n + (i & 3); }

struct Unit { int pm, pn, seg, ks, nt, koff; };
struct Gemm { const char* A; const char* Bt; int lda, ldb, K; size_t segA, segB; };

struct StaticOrder {
    int nM, nN, nwg, G, c, wgm;
    __device__ __forceinline__ void init(int M, int N, int G_, int c_) { nM = M / BM; nN = N / BM; nwg = nM * nN; G = G_; c = c_; wgm = nN <= 8 ? 4 : WGM; }
    __device__ __forceinline__ bool unit(int i, Unit& u) const {
        const long L = (long)i * G + c; const bool ok = L < nwg;
        int wgid = ok ? (int)L : 0; { const int q = nwg / NXCD, r = nwg % NXCD, xcd = wgid % NXCD, off = wgid / NXCD; wgid = (xcd < r ? xcd * (q + 1) : r * (q + 1) + (xcd - r) * q) + off; }
        const int nig = wgm * nN, gid = wgid / nig, fm = gid * wgm, gsz = (nM - fm) < wgm ? (nM - fm) : wgm;
        u.pm = fm + ((wgid % nig) % gsz); u.pn = (wgid % nig) / gsz; return ok;
    }
    int ntk;
    __device__ __forceinline__ bool next(int i, Unit& u) const { u.seg = 0; u.ks = -1; u.nt = ntk; u.koff = 0; return unit(i, u); }
};
struct SplitOrder : StaticOrder {
    __device__ __forceinline__ bool next(int i, Unit& u) const {
        Unit a; const bool oka = unit(i < 2 ? i : 0, a);
        const bool sp = i >= 2; const int tile = c >> 3;
        u.seg = 0; u.pm = sp ? 64 + (tile >> 3) : a.pm; u.pn = sp ? (tile & 7) : a.pn; u.ks = sp ? (c & 7) : -1; u.nt = sp ? (ntk >> 3) : ntk; u.koff = sp ? (c & 7) * (ntk >> 3) * (BK * 2) : 0;
        return sp ? (i == 2 && c < 256) : oka;
    }
};
struct Seg3Order : StaticOrder {
    __device__ __forceinline__ bool next(int i, Unit& u) const { const int t = i / 3; u.seg = i - 3 * t; u.ks = -1; u.nt = ntk; u.koff = 0; return unit(t, u); }
};
struct SegSubOrder {
    int c;
    __device__ __forceinline__ bool next(int i, Unit& u) const {
        const int tile = c / 3, sg = c - 3 * tile;
        u.pm = 64 + (tile >> 3); u.pn = tile & 7; u.seg = sg; u.ks = sg; u.nt = 1024 / BK; u.koff = 0;
        return i == 0 && c < 96;
    }
};
struct UpOrder {
    int c, G, ntk;
    __device__ __forceinline__ bool next(int i, Unit& u) const {
        const int x = c & 7, j = c >> 3; const bool last = i >= 8, lin = G != 256; const int L = i * G + c;
        const int pm = last ? 64 + (x >> 1) : 8 * i + 4 * (x >> 2) + (j & 3), pn = last ? 16 * (x & 1) + (j & 15) : 8 * (x & 3) + (j >> 2);
        u.pm = lin ? (L >> 5) : pm; u.pn = lin ? (L & 31) : pn; u.seg = 0; u.ks = -1; u.nt = ntk; u.koff = 0;
        return lin ? (L < (MT / BM) * (DFF / BM)) : (last ? (i == 8 && j < 16) : true);
    }
};
struct KvOrder {
    int c;
    __device__ __forceinline__ bool next(int i, Unit& u) const { if (i > 0 || c < 80 || c >= 144) return false; const int k = c - 80; u.pm = k & 1; u.pn = k >> 1; u.seg = 0; u.ks = -1; u.nt = DM / BK; u.koff = 0; return true; }
};

typedef int v4i_t __attribute__((ext_vector_type(4)));
template <bool I8> __device__ __forceinline__ f32x4 mma16(bf16x8 b, bf16x8 a, f32x4 c) {
    if constexpr (I8) return __builtin_bit_cast(f32x4, __builtin_amdgcn_mfma_i32_16x16x64_i8(__builtin_bit_cast(v4i_t, b), __builtin_bit_cast(v4i_t, a), __builtin_bit_cast(v4i_t, c), 0, 0, 0));
    else return __builtin_amdgcn_mfma_f32_16x16x32_bf16(b, a, c, 0, 0, 0);
}
template <class T, class = void> struct epi_wide { static constexpr bool value = false; };
template <class T> struct epi_wide<T, decltype((void)T::WIDE)> { static constexpr bool value = true; };
template <class Epi, class Sched, bool I8 = false>
__device__ __forceinline__ void gemm_phase(LAS unsigned char* lds, const Gemm g, const Sched& S, const Epi& E) {
    int tid = threadIdx.x; asm volatile("" : "+v"(tid));
    const int wid = __builtin_amdgcn_readfirstlane(tid >> 6), lane = tid & 63, wr = wid >> 2, wc = wid & 3, fr = lane & 15, fq = lane >> 4;
    unsigned voffA[2], voffB[2];
#pragma unroll
    for (int i = 0; i < 2; ++i) { int R, C; stage_rc(tid * 16 + i * 8192, R, C); const int Rb = Epi::PERM ? ((R >> 5) * 64 + perm32(R & 31)) : R;
        voffA[i] = (unsigned)(R * g.lda + C) * 2u; voffB[i] = (unsigned)(Rb * g.ldb + C) * 2u; }
    const size_t kstep = (size_t)(BK * 2);
    const size_t hstepA = (size_t)HALF * g.lda * 2, hstepB = (size_t)(Epi::PERM ? 32 : HALF) * g.ldb * 2;
    const size_t tstepA = 2 * hstepA, tstepB = (size_t)BM * g.ldb * 2;
    const unsigned ldsw = (unsigned)wid * 1024u;
    const int aoff = lds_byte(wr * 64 + fr, fq * 8), boff = lds_byte(wc * 32 + fr, fq * 8);
#define PG8_SA(b, h) (((b) * 2 + (h)) * HTB)
#define PG8_SB(b, h) ((4 + (b) * 2 + (h)) * HTB)
#define PG8_STAGE(bufoff, gbase, voff) do { _Pragma("unroll") for (int _i = 0; _i < 2; ++_i) \
        __builtin_amdgcn_global_load_lds((const unsigned*)((const char*)(gbase) + (voff)[_i]), (LAS unsigned*)(lds + (bufoff) + ldsw + _i * 8192), 16, 0, 0); } while (0)
#define PG8_LDA(dst, b, h) do { _Pragma("unroll") for (int m = 0; m < 4; ++m) _Pragma("unroll") for (int k = 0; k < 2; ++k) dst[m][k] = *(const LAS bf16x8*)(lds + PG8_SA(b, h) + aoff + m * 2048 + k * 1024); } while (0)
#define PG8_LDB(dst, b, h) do { _Pragma("unroll") for (int n = 0; n < 2; ++n) _Pragma("unroll") for (int k = 0; k < 2; ++k) dst[n][k] = *(const LAS bf16x8*)(lds + PG8_SB(b, h) + boff + n * 2048 + k * 1024); } while (0)
#define PG8_MMA(ai, bj, At, Bt) do { __builtin_amdgcn_s_setprio(1); _Pragma("unroll") for (int m = 0; m < 4; ++m) _Pragma("unroll") for (int n = 0; n < 2; ++n) _Pragma("unroll") for (int k = 0; k < 2; ++k) \
        acc[ai][bj][m][n] = mma16<I8>(Bt[n][k], At[m][k], acc[ai][bj][m][n]); __builtin_amdgcn_s_setprio(0); } while (0)
#define PG8_WAIT_V(n) asm volatile("s_waitcnt vmcnt(" #n ")" ::: "memory")
#define PG8_WAIT_L(n) asm volatile("s_waitcnt lgkmcnt(" #n ")" ::: "memory")
#define PG8_BAR __builtin_amdgcn_s_barrier()
#define PG8_SCHED __builtin_amdgcn_sched_barrier(0)
    Unit cur, nxt; int ui = 0;
    if (!S.next(0, cur)) return;
    f32x4 acc[2][2][4][2];
#pragma unroll
    for (int a = 0; a < 2; ++a)
#pragma unroll
        for (int b = 0; b < 2; ++b)
#pragma unroll
            for (int m = 0; m < 4; ++m)
#pragma unroll
                for (int n = 0; n < 2; ++n) acc[a][b][m][n] = (f32x4){0.f, 0.f, 0.f, 0.f};
    bf16x8 At[4][2], B0[2][2], B1[2][2];
    const char* cA = g.A + (size_t)cur.seg * g.segA + (size_t)cur.pm * tstepA + cur.koff; const char* cB = g.Bt + (size_t)cur.seg * g.segB + (size_t)cur.pn * tstepB + cur.koff;
    if (PG8_SP2) {
    PG8_STAGE(PG8_SB(0, 0), cB, voffB); PG8_STAGE(PG8_SB(0, 1), cB + hstepB, voffB); PG8_STAGE(PG8_SA(0, 0), cA, voffA); PG8_STAGE(PG8_SA(0, 1), cA + hstepA, voffA);
    if (wr == 1) PG8_BAR;
    PG8_WAIT_V(2); PG8_BAR;
    PG8_STAGE(PG8_SB(1, 0), cB + kstep, voffB); PG8_STAGE(PG8_SA(1, 0), cA + kstep, voffA); PG8_STAGE(PG8_SB(1, 1), cB + hstepB + kstep, voffB);
    PG8_WAIT_V(6); PG8_BAR;
    } else {
    PG8_STAGE(PG8_SB(0, 0), cB, voffB); PG8_STAGE(PG8_SA(0, 0), cA, voffA); PG8_STAGE(PG8_SB(0, 1), cB + hstepB, voffB); PG8_STAGE(PG8_SA(0, 1), cA + hstepA, voffA);
    if (wr == 1) PG8_BAR;
    PG8_WAIT_V(4); PG8_BAR;
    PG8_STAGE(PG8_SB(1, 0), cB + kstep, voffB); PG8_STAGE(PG8_SA(1, 0), cA + kstep, voffA); PG8_STAGE(PG8_SB(1, 1), cB + hstepB + kstep, voffB);
    PG8_WAIT_V(6); PG8_BAR;
    }
    for (;;) {
        const bool has_next = S.next(ui + 1, nxt);
        const char* nA = has_next ? g.A + (size_t)nxt.seg * g.segA + (size_t)nxt.pm * tstepA + nxt.koff : cA; const char* nB = has_next ? g.Bt + (size_t)nxt.seg * g.segB + (size_t)nxt.pn * tstepB + nxt.koff : cB;
        const int nt = cur.nt;
        for (int t = 0; t < nt; t += 2) {
            const bool last = (t == nt - 2);
            const char* a1 = cA + (size_t)(t + 1) * kstep;
            const char* a2 = last ? nA : cA + (size_t)(t + 2) * kstep; const char* b2 = last ? nB : cB + (size_t)(t + 2) * kstep;
            const char* a3 = a2 + kstep; const char* b3 = b2 + kstep;
            if (PG8_SP2) {
            PG8_LDB(B0, 0, 0); PG8_LDB(B1, 0, 1); PG8_SCHED; PG8_LDA(At, 0, 0); PG8_STAGE(PG8_SA(1, 1), a1 + hstepA, voffA);
            PG8_WAIT_V(8); PG8_WAIT_L(0); PG8_BAR; PG8_MMA(0, 0, At, B0); PG8_MMA(0, 1, At, B1); PG8_BAR; PG8_SCHED;
            PG8_LDA(At, 0, 1); PG8_STAGE(PG8_SB(0, 0), b2, voffB); PG8_STAGE(PG8_SB(0, 1), b2 + hstepB, voffB); PG8_STAGE(PG8_SA(0, 0), a2, voffA);
            PG8_WAIT_V(8); PG8_WAIT_L(0); PG8_BAR; PG8_MMA(1, 0, At, B0); PG8_MMA(1, 1, At, B1); PG8_BAR; PG8_SCHED;
            PG8_LDB(B0, 1, 0); PG8_LDB(B1, 1, 1); PG8_SCHED; PG8_LDA(At, 1, 0); PG8_STAGE(PG8_SA(0, 1), a2 + hstepA, voffA);
            PG8_WAIT_V(8); PG8_WAIT_L(0); PG8_BAR; PG8_MMA(0, 0, At, B0); PG8_MMA(0, 1, At, B1); PG8_BAR; PG8_SCHED;
            PG8_LDA(At, 1, 1); PG8_STAGE(PG8_SB(1, 0), b3, voffB); PG8_STAGE(PG8_SB(1, 1), b3 + hstepB, voffB); PG8_STAGE(PG8_SA(1, 0), a3, voffA);
            PG8_WAIT_V(8); PG8_WAIT_L(0); PG8_BAR; PG8_MMA(1, 0, At, B0); PG8_MMA(1, 1, At, B1); PG8_BAR; PG8_SCHED;
            } else {
            PG8_LDB(B0, 0, 0); PG8_SCHED; PG8_LDA(At, 0, 0); PG8_STAGE(PG8_SA(1, 1), a1 + hstepA, voffA);
            PG8_WAIT_L(8); PG8_BAR; PG8_WAIT_L(0); PG8_MMA(0, 0, At, B0); PG8_BAR; PG8_SCHED;
            PG8_LDB(B1, 0, 1); PG8_STAGE(PG8_SB(0, 0), b2, voffB);
            PG8_BAR; PG8_WAIT_L(0); PG8_MMA(0, 1, At, B1); PG8_BAR;
            PG8_LDA(At, 0, 1); PG8_STAGE(PG8_SA(0, 0), a2, voffA);
            PG8_BAR; PG8_WAIT_L(0); PG8_MMA(1, 0, At, B0); PG8_BAR; PG8_SCHED;
            PG8_STAGE(PG8_SB(0, 1), b2 + hstepB, voffB);
            PG8_WAIT_V(6); PG8_BAR; PG8_MMA(1, 1, At, B1); PG8_BAR;
            PG8_LDB(B0, 1, 0); PG8_SCHED; PG8_LDA(At, 1, 0); PG8_STAGE(PG8_SA(0, 1), a2 + hstepA, voffA);
            PG8_WAIT_L(8); PG8_BAR; PG8_WAIT_L(0); PG8_MMA(0, 0, At, B0); PG8_BAR; PG8_SCHED;
            PG8_LDB(B1, 1, 1); PG8_STAGE(PG8_SB(1, 0), b3, voffB);
            PG8_BAR; PG8_WAIT_L(0); PG8_MMA(0, 1, At, B1); PG8_BAR;
            PG8_LDA(At, 1, 1); PG8_STAGE(PG8_SA(1, 0), a3, voffA);
            PG8_BAR; PG8_WAIT_L(0); PG8_MMA(1, 0, At, B0); PG8_BAR; PG8_SCHED;
            PG8_STAGE(PG8_SB(1, 1), b3 + hstepB, voffB);
            PG8_WAIT_V(6); PG8_BAR; PG8_MMA(1, 1, At, B1); PG8_BAR;
            }
        }
        if (PG8_ALIGN) { if (wr == 0) PG8_BAR; }
        { Unit eu = cur; eu.pm = __builtin_amdgcn_readfirstlane(eu.pm); eu.pn = __builtin_amdgcn_readfirstlane(eu.pn); eu.seg = __builtin_amdgcn_readfirstlane(eu.seg); eu.ks = __builtin_amdgcn_readfirstlane(eu.ks); asm volatile("" : "+s"(eu.pm), "+s"(eu.pn), "+s"(eu.seg), "+s"(eu.ks));
          if constexpr (epi_wide<Epi>::value) E(acc, eu, wr, wc, fr, fq, wid, lds); else E(acc, eu, wr, wc, fr, fq); }
        if (!has_next) break;
        if (nxt.seg == 0 || nxt.ks >= 0) {
#pragma unroll
            for (int a = 0; a < 2; ++a)
#pragma unroll
                for (int b = 0; b < 2; ++b)
#pragma unroll
                    for (int m = 0; m < 4; ++m)
#pragma unroll
                        for (int n = 0; n < 2; ++n) acc[a][b][m][n] = (f32x4){0.f, 0.f, 0.f, 0.f};
        }
        cur = nxt; cA = nA; cB = nB; ++ui;
        if (PG8_ALIGN) { if (wr == 1) PG8_BAR; }
    }
    PG8_WAIT_V(0);
    if (!PG8_ALIGN) { if (wr == 0) PG8_BAR; }
    PG8_BAR;
#undef PG8_SA
#undef PG8_SB
#undef PG8_STAGE
#undef PG8_LDA
#undef PG8_LDB
#undef PG8_MMA
#undef PG8_WAIT_V
#undef PG8_WAIT_L
#undef PG8_BAR
#undef PG8_SCHED
}

constexpr int CBJ = 32;
__device__ __forceinline__ unsigned dpp_ror8(unsigned v) { return (unsigned)__builtin_amdgcn_update_dpp(0, (int)v, 0x128, 0xF, 0xF, false); }
__device__ __forceinline__ void store_pair(bf16_t* grp  , size_t ld, int fr, int fq, u32x4 P0, u32x4 P1) {
    const bool up = (fr & 8) != 0;
    u32x4 snd, rcv;
    snd.x = up ? P0.x : P1.x; snd.y = up ? P0.y : P1.y; snd.z = up ? P0.z : P1.z; snd.w = up ? P0.w : P1.w;
    rcv.x = dpp_ror8(snd.x); rcv.y = dpp_ror8(snd.y); rcv.z = dpp_ror8(snd.z); rcv.w = dpp_ror8(snd.w);
    u32x4 dA, dB;
    dA.x = up ? rcv.x : P0.x; dA.y = up ? rcv.y : P0.y; dA.z = up ? rcv.z : P0.z; dA.w = up ? rcv.w : P0.w;
    dB.x = up ? P1.x : rcv.x; dB.y = up ? P1.y : rcv.y; dB.z = up ? P1.z : rcv.z; dB.w = up ? P1.w : rcv.w;
    bf16_t* p = grp + (size_t)(fr & 7) * ld + (up ? CBJ : 0) + 8 * fq;
    __builtin_nontemporal_store(dA, (u32x4*)p); __builtin_nontemporal_store(dB, (u32x4*)(p + 8 * ld));
}
__device__ __forceinline__ void store_pair8(unsigned char* grp  , size_t ld, int fr, int fq, u32x2 P0, u32x2 P1) {
    const bool up = (fr & 8) != 0;
    u32x2 snd, rcv, dA, dB;
    snd.x = up ? P0.x : P1.x; snd.y = up ? P0.y : P1.y;
    rcv.x = dpp_ror8(snd.x); rcv.y = dpp_ror8(snd.y);
    dA.x = up ? rcv.x : P0.x; dA.y = up ? rcv.y : P0.y;
    dB.x = up ? P1.x : rcv.x; dB.y = up ? P1.y : rcv.y;
    unsigned char* p = grp + (size_t)(fr & 7) * ld + (up ? CBJ : 0) + 8 * fq;
    __builtin_nontemporal_store(dA, (u32x2*)p); __builtin_nontemporal_store(dB, (u32x2*)(p + 8 * ld));
}
__device__ __forceinline__ unsigned gate_byte(float g) { return (unsigned)(int)__builtin_amdgcn_fmed3f(__builtin_rintf(g * 255.0f), 1.0f, 255.0f); }
__device__ __forceinline__ void unpack8u(u32x2 w, f32x4& a, f32x4& b) {
    a = (f32x4){(float)(w.x & 255u), (float)((w.x >> 8) & 255u), (float)((w.x >> 16) & 255u), (float)(w.x >> 24)};
    b = (f32x4){(float)(w.y & 255u), (float)((w.y >> 8) & 255u), (float)((w.y >> 16) & 255u), (float)(w.y >> 24)};
}
__device__ __forceinline__ size_t g8_tile(int pm, int gt) { return ((size_t)pm * 24 + gt) * 65536; }
struct EpiIn {
    static constexpr bool PERM = true;
    bf16_t* P; const float* bgate;
    __device__ __forceinline__ void operator()(f32x4 (&acc)[2][2][4][2], const Unit& u, int wr, int wc, int fr, int fq) const {
        const int rowg = u.pm * BM + wr * 64, colw = u.pn * BM + wc * 64, col0 = colw + 8 * fq, grp = u.pn >> 2;
        const int mode = grp == 1 ? 1 : (grp == 5 ? 2 : (grp >= 6 ? 3 : 0));
#pragma unroll
        for (int ai = 0; ai < 2; ++ai)
#pragma unroll
            for (int m = 0; m < 4; ++m) {
                u32x4 pk[2];
#pragma unroll
                for (int bj = 0; bj < 2; ++bj) {
                    f32x4 v0 = acc[ai][bj][m][0], v1 = acc[ai][bj][m][1];
                    if (mode == 1) {
#pragma unroll
                        for (int j = 0; j < 4; ++j) { v0[j] = fgelu_tanh(v0[j]); v1[j] = fgelu_tanh(v1[j]); }
                    } else if (mode == 2) { v0 = v0 * (0.0625f * LOG2E); v1 = v1 * (0.0625f * LOG2E); }
                    else if (mode == 3) {
                        v0 = v0 + *(const f32x4*)(bgate + (col0 - C_GT) + bj * CBJ); v1 = v1 + *(const f32x4*)(bgate + (col0 - C_GT) + bj * CBJ + 4);
#pragma unroll
                        for (int j = 0; j < 4; ++j) { v0[j] = fsigmoid(v0[j]); v1[j] = fsigmoid(v1[j]); }
                    }
                    pk[bj] = pack8(v0, v1);
                }
                store_pair(P + (size_t)(rowg + ai * HALF + m * 16) * INC + colw, INC, fr, fq, pk[0], pk[1]);
            }
    }
};
struct EpiIn8 {
    static constexpr bool PERM = true;
    bf16_t* P; const float* bgate; const float* sa; const unsigned* cmax; unsigned char* G8;
    __device__ __forceinline__ void operator()(f32x4 (&acc)[2][2][4][2], const Unit& u, int wr, int wc, int fr, int fq) const {
        const int rowg = u.pm * BM + wr * 64, colw = u.pn * BM + wc * 64, col0 = colw + 8 * fq;
        const int grp = (u.pn + C_I8 / BM) >> 2, mode = grp >= 6 ? 3 : (grp == 5 ? 2 : 0);
        if (mode == 3) {
            f32x4 cn[4], bn[4];
#pragma unroll
            for (int k = 0; k < 4; ++k) { const u32x4 c_ = *(const u32x4*)(cmax + col0 + (k >> 1) * CBJ + (k & 1) * 4); const f32x4 b_ = *(const f32x4*)(bgate + (col0 + C_I8 - C_GT) + (k >> 1) * CBJ + (k & 1) * 4);
#pragma unroll
                for (int j = 0; j < 4; ++j) { cn[k][j] = __uint_as_float(c_[j]) * -LOG2E; bn[k][j] = b_[j] * -LOG2E; } }
            float sv[8];
#pragma unroll
            for (int k = 0; k < 8; ++k) sv[k] = sa[rowg + (k >> 2) * HALF + (k & 3) * 16 + fr] * (1.0f / 127.0f);
#pragma unroll
            for (int ai = 0; ai < 2; ++ai)
#pragma unroll
                for (int m = 0; m < 4; ++m) {
                    const float s = sv[ai * 4 + m];
                    u32x2 gb[2];
#pragma unroll
                    for (int bj = 0; bj < 2; ++bj) {
                        const v4i_t i0 = __builtin_bit_cast(v4i_t, acc[ai][bj][m][0]), i1 = __builtin_bit_cast(v4i_t, acc[ai][bj][m][1]);
                        unsigned w0 = 0u, w1 = 0u;
#pragma unroll
                        for (int j = 0; j < 4; ++j) {
                            const float e0 = __builtin_amdgcn_exp2f(__builtin_fmaf((float)i0[j], s * cn[bj * 2][j], bn[bj * 2][j])), e1 = __builtin_amdgcn_exp2f(__builtin_fmaf((float)i1[j], s * cn[bj * 2 + 1][j], bn[bj * 2 + 1][j]));
                            const float g0 = __builtin_amdgcn_rcpf(__builtin_fmaf(e0, 1.0f / 255.0f, 1.0f / 255.0f)), g1 = __builtin_amdgcn_rcpf(__builtin_fmaf(e1, 1.0f / 255.0f, 1.0f / 255.0f));
                            w0 = __builtin_amdgcn_cvt_pk_u8_f32(fmaxf(g0, 1.0f), j, w0); w1 = __builtin_amdgcn_cvt_pk_u8_f32(fmaxf(g1, 1.0f), j, w1);
                        }
                        gb[bj].x = w0; gb[bj].y = w1;
                    }
                    unsigned char* gq = G8 + g8_tile(u.pm, u.pn - (C_GT - C_I8) / BM) + (wr * 4 + wc) * 8192 + (ai * 4 + m) * 1024 + (fq * 16 + fr) * 8;
                    __builtin_nontemporal_store(gb[0], (u32x2*)gq); __builtin_nontemporal_store(gb[1], (u32x2*)(gq + 512));
                }
            return;
        }
        f32x4 cq[4]; float sq[8];
        const float qs = mode == 2 ? 0.0625f * LOG2E : 1.0f;
#pragma unroll
        for (int k = 0; k < 4; ++k) { const u32x4 c_ = *(const u32x4*)(cmax + col0 + (k >> 1) * CBJ + (k & 1) * 4);
#pragma unroll
            for (int j = 0; j < 4; ++j) cq[k][j] = __uint_as_float(c_[j]) * qs; }
#pragma unroll
        for (int k = 0; k < 8; ++k) sq[k] = sa[rowg + (k >> 2) * HALF + (k & 3) * 16 + fr] * (1.0f / 127.0f);
#pragma unroll
        for (int ai = 0; ai < 2; ++ai)
#pragma unroll
            for (int m = 0; m < 4; ++m) {
                const float s = sq[ai * 4 + m];
                u32x4 pk[2];
#pragma unroll
                for (int bj = 0; bj < 2; ++bj) {
                    const v4i_t i0 = __builtin_bit_cast(v4i_t, acc[ai][bj][m][0]), i1 = __builtin_bit_cast(v4i_t, acc[ai][bj][m][1]);
                    f32x4 v0, v1;
#pragma unroll
                    for (int j = 0; j < 4; ++j) { v0[j] = (float)i0[j] * (s * cq[bj * 2][j]); v1[j] = (float)i1[j] * (s * cq[bj * 2 + 1][j]); }
                    pk[bj] = pack8(v0, v1);
                }
                store_pair(P + (size_t)(rowg + ai * HALF + m * 16) * INC + C_I8 + colw, INC, fr, fq, pk[0], pk[1]);
            }
    }
};
struct EpiUp {
    static constexpr bool PERM = true;
    bf16_t* H;
    __device__ __forceinline__ void operator()(f32x4 (&acc)[2][2][4][2], const Unit& u, int wr, int wc, int fr, int fq) const {
        const int rowg = u.pm * BM + wr * 64, colw = u.pn * BM + wc * 64;
#pragma unroll
        for (int ai = 0; ai < 2; ++ai)
#pragma unroll
            for (int m = 0; m < 4; ++m) {
                u32x4 pk[2];
#pragma unroll
                for (int bj = 0; bj < 2; ++bj) {
                    f32x4 v0 = acc[ai][bj][m][0], v1 = acc[ai][bj][m][1];
#pragma unroll
                    for (int j = 0; j < 4; ++j) { const float a = fmaxf(v0[j], 0.f), b = fmaxf(v1[j], 0.f); v0[j] = a * a; v1[j] = b * b; }
                    pk[bj] = pack8(v0, v1);
                }
                store_pair(H + (size_t)(rowg + ai * HALF + m * 16) * DFF + colw, DFF, fr, fq, pk[0], pk[1]);
            }
    }
};
struct EpiUp8 {
    static constexpr bool PERM = true, WIDE = true;
    unsigned char* ws; int l, tl;
#define UP8_CTL  ((unsigned*)(ws + WS_CTL))
#define UP8_H8   (ws + WS_PROJ)
#define UP8_SA   ((const float*)(ws + WS_SA))
#define UP8_CMAX ((const unsigned*)(ws + WS_CTL) + CW_CMAX + l * CM_L + NI8)
#define UP8_RMAX (UP8_CTL + CW_RMAX + l * MT)
#define UP8_RCNT (UP8_CTL + CW_RCNT)
#define UP8_TMO  (UP8_CTL + 4096 + 128)
#define UP8_TGT  (128u * (unsigned)tl)
    __device__ __forceinline__ void wait_posts(unsigned* cnt, unsigned have) const {
        const unsigned target = UP8_TGT; unsigned* tmo = UP8_TMO; unsigned sp = 0; while (have < target) { __builtin_amdgcn_s_sleep(1); have = __hip_atomic_load(cnt, __ATOMIC_RELAXED, __HIP_MEMORY_SCOPE_AGENT);
            if ((++sp & 255u) == 0u) { if (__hip_atomic_load(tmo, __ATOMIC_RELAXED, __HIP_MEMORY_SCOPE_AGENT)) break; if (sp > (1u << 18)) { atomicAdd(tmo, 1u); break; } } }
        asm volatile("" ::: "memory");
    }
    __device__ __forceinline__ void load_rmax(int pm, int wr, int fr_in, float (&rmv)[8]) const {
        int fr = fr_in; asm volatile("" : "+v"(fr));
        const unsigned* rp = UP8_RMAX + pm * BM + wr * 64 + fr;
#pragma unroll
        for (int k = 0; k < 8; ++k) rmv[k] = __uint_as_float(__hip_atomic_load(rp + (k >> 2) * HALF + (k & 3) * 16, __ATOMIC_RELAXED, __HIP_MEMORY_SCOPE_AGENT));
    }
    __device__ __forceinline__ void operator()(f32x4 (&acc)[2][2][4][2], const Unit& u, int wr, int wc, int fr_in, int fq_in, int wid, LAS unsigned char* lds) const {
        int fr = fr_in, fq = fq_in; asm volatile("" : "+v"(fr), "+v"(fq));
        const float* sa = UP8_SA; const unsigned* cmax = UP8_CMAX; unsigned* rmax = UP8_RMAX; unsigned* rcnt = UP8_RCNT;
        const int rowg = u.pm * BM + wr * 64, colw = u.pn * BM + wc * 64, lane = fq * 16 + fr;
        unsigned* pcnt = rcnt + u.pm * 32;
        LAS float* lmx = (LAS float*)(lds + MISC_OFF + 1024);
        float sv[8]; u32x4 cv[4];
#pragma unroll
        for (int k = 0; k < 8; ++k) sv[k] = sa[rowg + (k >> 2) * HALF + (k & 3) * 16 + fr] * (1.0f / 127.0f);
#pragma unroll
        for (int k = 0; k < 4; ++k) cv[k] = *(const u32x4*)(cmax + colw + 8 * fq + (k >> 1) * CBJ + (k & 1) * 4);
#pragma unroll
        for (int ai = 0; ai < 2; ++ai)
#pragma unroll
            for (int m = 0; m < 4; ++m) {
                const float s = sv[ai * 4 + m];
                float mx = 0.f;
#pragma unroll
                for (int bj = 0; bj < 2; ++bj) {
                    const v4i_t i0 = __builtin_bit_cast(v4i_t, acc[ai][bj][m][0]), i1 = __builtin_bit_cast(v4i_t, acc[ai][bj][m][1]);
                    const u32x4 c0_ = cv[bj * 2], c1_ = cv[bj * 2 + 1];
                    f32x4 v0, v1;
#pragma unroll
                    for (int j = 0; j < 4; ++j) { const float a = fmaxf((float)i0[j] * (s * __uint_as_float(c0_[j])), 0.f), b = fmaxf((float)i1[j] * (s * __uint_as_float(c1_[j])), 0.f); v0[j] = a * a; v1[j] = b * b; mx = fmaxf(mx, fmaxf(v0[j], v1[j])); }
                    acc[ai][bj][m][0] = v0; acc[ai][bj][m][1] = v1;
                }
                mx = fmaxf(mx, __shfl_xor(mx, 16)); mx = fmaxf(mx, __shfl_xor(mx, 32));
                if (fq == 0) lmx[wc * 256 + wr * 64 + ai * HALF + m * 16 + fr] = mx;
            }
        LDS_WAIT(); __builtin_amdgcn_s_barrier();
        if (wid < 4) {
            const int r = wid * 64 + lane;
            const float m4 = fmaxf(fmaxf(lmx[r], lmx[256 + r]), fmaxf(lmx[512 + r], lmx[768 + r]));
            const unsigned old = __hip_atomic_fetch_max(rmax + u.pm * BM + r, __float_as_uint(m4), __ATOMIC_RELAXED, __HIP_MEMORY_SCOPE_AGENT);
            asm volatile("" :: "v"(old) : "memory");
            if (lane == 0) (void)__hip_atomic_fetch_add(pcnt, 1u, __ATOMIC_RELAXED, __HIP_MEMORY_SCOPE_AGENT);
        }
        if (wid == 0) wait_posts(pcnt, __hip_atomic_load(pcnt, __ATOMIC_RELAXED, __HIP_MEMORY_SCOPE_AGENT));
        __builtin_amdgcn_s_barrier();
        LAS float* lfin = lmx + 1024;
        if (wid < 4) lfin[wid * 64 + lane] = __uint_as_float(__hip_atomic_load(rmax + u.pm * BM + wid * 64 + lane, __ATOMIC_RELAXED, __HIP_MEMORY_SCOPE_AGENT));
        LDS_WAIT(); __builtin_amdgcn_s_barrier();
        float rmv[8];
#pragma unroll
        for (int k = 0; k < 8; ++k) rmv[k] = lfin[wr * 64 + (k >> 2) * HALF + (k & 3) * 16 + fr];
        unsigned char* H8 = UP8_H8;
#pragma unroll
        for (int ai = 0; ai < 2; ++ai)
#pragma unroll
            for (int m = 0; m < 4; ++m) {
                const float rm = rmv[ai * 4 + m], inv = rm > 0.f ? 255.0f * __builtin_amdgcn_rcpf(rm) : 0.f;
                u32x2 gb[2];
#pragma unroll
                for (int bj = 0; bj < 2; ++bj) {
                    const f32x4 v0 = acc[ai][bj][m][0], v1 = acc[ai][bj][m][1];
                    unsigned w0 = 0u, w1 = 0u;
#pragma unroll
                    for (int j = 0; j < 4; ++j) { w0 = __builtin_amdgcn_cvt_pk_u8_f32(__builtin_rintf(v0[j] * inv), j, w0); w1 = __builtin_amdgcn_cvt_pk_u8_f32(__builtin_rintf(v1[j] * inv), j, w1); }
                    gb[bj].x = w0 ^ 0x80808080u; gb[bj].y = w1 ^ 0x80808080u;
                }
                store_pair8(H8 + (size_t)(rowg + ai * HALF + m * 16) * DFF + colw, DFF, fr, fq, gb[0], gb[1]);
            }
    }
#undef UP8_CTL
#undef UP8_H8
#undef UP8_SA
#undef UP8_CMAX
#undef UP8_RMAX
#undef UP8_RCNT
#undef UP8_TMO
#undef UP8_TGT
};
struct EpiY8 {
    static constexpr bool PERM = true;
    bf16_t* Y; float* ssy; float* yp; const unsigned* rmax; const unsigned* cmax; const int* csum;
    __device__ __forceinline__ void operator()(f32x4 (&acc)[2][2][4][2], const Unit& u, int wr, int wc, int fr, int fq) const {
        const int rowg = u.pm * BM + wr * 64, colw = u.pn * BM + wc * 64, row0 = rowg + fr, col0 = colw + 8 * fq;
        u32x4 cv[4]; v4i_t ov[4];
#pragma unroll
        for (int k = 0; k < 4; ++k) { cv[k] = *(const u32x4*)(cmax + col0 + (k >> 1) * CBJ + (k & 1) * 4); ov[k] = *(const v4i_t*)(csum + (u.ks < 0 ? 0 : (1 + u.ks) * DM) + col0 + (k >> 1) * CBJ + (k & 1) * 4); }
        float rv[8];
#pragma unroll
        for (int k = 0; k < 8; ++k) rv[k] = __uint_as_float(rmax[row0 + (k >> 2) * HALF + (k & 3) * 16]) * (1.0f / (255.0f * 127.0f));
#pragma unroll
        for (int ai = 0; ai < 2; ++ai)
#pragma unroll
            for (int m = 0; m < 4; ++m) {
                const int row = row0 + ai * HALF + m * 16;
                const float sr = rv[ai * 4 + m];
                float s = 0.f; u32x4 pk[2];
#pragma unroll
                for (int bj = 0; bj < 2; ++bj) {
                    const v4i_t i0 = __builtin_bit_cast(v4i_t, acc[ai][bj][m][0]) + ov[bj * 2], i1 = __builtin_bit_cast(v4i_t, acc[ai][bj][m][1]) + ov[bj * 2 + 1];
                    const u32x4 c0_ = cv[bj * 2], c1_ = cv[bj * 2 + 1];
                    f32x4 v0, v1;
#pragma unroll
                    for (int j = 0; j < 4; ++j) { v0[j] = (float)i0[j] * (sr * __uint_as_float(c0_[j])); v1[j] = (float)i1[j] * (sr * __uint_as_float(c1_[j])); }
                    s += (v0[0] * v0[0] + v0[1] * v0[1]) + (v0[2] * v0[2] + v0[3] * v0[3]) + (v1[0] * v1[0] + v1[1] * v1[1]) + (v1[2] * v1[2] + v1[3] * v1[3]);
                    pk[bj] = pack8(v0, v1);
                }
                if (u.ks >= 0) store_pair((bf16_t*)yp + ((size_t)u.ks * MS + (rowg - MP) + ai * HALF + m * 16) * DM + colw, DM, fr, fq, pk[0], pk[1]);
                else {
                    store_pair(Y + (size_t)(rowg + ai * HALF + m * 16) * DM + colw, DM, fr, fq, pk[0], pk[1]);
                    s += __shfl_xor(s, 16); s += __shfl_xor(s, 32);
                    if (fq == 0) ssy[(size_t)row * 32 + u.pn * 4 + wc] = s;
                }
            }
    }
};
struct EpiY {
    static constexpr bool PERM = true;
    bf16_t* Y; float* ssy; float* yp;
    __device__ __forceinline__ void operator()(f32x4 (&acc)[2][2][4][2], const Unit& u, int wr, int wc, int fr, int fq) const {
        const int rowg = u.pm * BM + wr * 64, colw = u.pn * BM + wc * 64, row0 = rowg + fr, col0 = colw + 8 * fq;
        if (u.ks >= 0) {
            bf16_t* base = (bf16_t*)yp + ((size_t)u.ks * MS + (rowg - MP)) * DM + colw;
#pragma unroll
            for (int ai = 0; ai < 2; ++ai)
#pragma unroll
                for (int m = 0; m < 4; ++m)
                    store_pair(base + (size_t)(ai * HALF + m * 16) * DM, DM, fr, fq, pack8(acc[ai][0][m][0], acc[ai][0][m][1]), pack8(acc[ai][1][m][0], acc[ai][1][m][1]));
            return;
        }
#pragma unroll
        for (int ai = 0; ai < 2; ++ai)
#pragma unroll
            for (int m = 0; m < 4; ++m) {
                const int row = row0 + ai * HALF + m * 16;
                float s = 0.f; u32x4 pk[2];
#pragma unroll
                for (int bj = 0; bj < 2; ++bj) {
                    const f32x4 v0 = acc[ai][bj][m][0], v1 = acc[ai][bj][m][1];
                    s += (v0[0] * v0[0] + v0[1] * v0[1]) + (v0[2] * v0[2] + v0[3] * v0[3]) + (v1[0] * v1[0] + v1[1] * v1[1]) + (v1[2] * v1[2] + v1[3] * v1[3]);
                    pk[bj] = pack8(v0, v1);
                }
                store_pair(Y + (size_t)(rowg + ai * HALF + m * 16) * DM + colw, DM, fr, fq, pk[0], pk[1]);
                s += __shfl_xor(s, 16); s += __shfl_xor(s, 32);
                if (fq == 0) ssy[(size_t)row * 32 + u.pn * 4 + wc] = s;
            }
    }
};
struct EpiBranch {
    static constexpr bool PERM = true;
    const unsigned char* G8; bf16_t* Mg;
    __device__ __forceinline__ void operator()(f32x4 (&acc)[2][2][4][2], const Unit& u, int wr, int wc, int fr, int fq) const {
        const int rowg = u.pm * BM + wr * 64, colw = u.pn * BM + wc * 64, row0 = rowg + fr, col0 = colw + 8 * fq, seg = u.seg;
        u32x2 gv[8][2], hv[8][2];
#pragma unroll
        for (int k = 0; k < 8; ++k) {
            const unsigned char* gp = G8 + g8_tile(u.pm, seg * 8 + u.pn) + (wr * 4 + wc) * 8192 + k * 1024 + (fq * 16 + fr) * 8;
#pragma unroll
            for (int bj = 0; bj < 2; ++bj) { gv[k][bj] = *(const u32x2*)(gp + bj * 512); if (seg < 2) hv[k][bj] = *(const u32x2*)(gp + 8 * 65536 + bj * 512); }
        }
#pragma unroll
        for (int ai = 0; ai < 2; ++ai)
#pragma unroll
            for (int m = 0; m < 4; ++m) {
                u32x4 pk[2];
#pragma unroll
                for (int bj = 0; bj < 2; ++bj) {
                    f32x4 g0, g1; unpack8u(gv[ai * 4 + m][bj], g0, g1);
                    if (seg < 2) {
                        f32x4 h0, h1; unpack8u(hv[ai * 4 + m][bj], h0, h1);
#pragma unroll
                        for (int j = 0; j < 4; ++j) { g0[j] = g0[j] * __builtin_amdgcn_rcpf(h0[j]); g1[j] = g1[j] * __builtin_amdgcn_rcpf(h1[j]); }
                        acc[ai][bj][m][0] = acc[ai][bj][m][0] * g0; acc[ai][bj][m][1] = acc[ai][bj][m][1] * g1;
                    } else pk[bj] = pack8(acc[ai][bj][m][0] * (g0 * (1.0f / 255.0f)), acc[ai][bj][m][1] * (g1 * (1.0f / 255.0f)));
                }
                if (seg == 2) store_pair(Mg + (size_t)(rowg + ai * HALF + m * 16) * DM + colw, DM, fr, fq, pk[0], pk[1]);
            }
    }
};
struct EpiPart {
    static constexpr bool PERM = true;
    float* bp;
    __device__ __forceinline__ void operator()(f32x4 (&acc)[2][2][4][2], const Unit& u, int wr, int wc, int fr, int fq) const {
        const int row0 = u.pm * BM + wr * 64 + fr, col0 = u.pn * BM + wc * 64 + 8 * fq;
        float* base = bp + ((size_t)u.seg * MS + (row0 - MP)) * DM + col0;
#pragma unroll
        for (int ai = 0; ai < 2; ++ai)
#pragma unroll
            for (int m = 0; m < 4; ++m)
#pragma unroll
                for (int bj = 0; bj < 2; ++bj) { float* op = base + (size_t)(ai * HALF + m * 16) * DM + bj * CBJ; *(f32x4*)op = acc[ai][bj][m][0]; *(f32x4*)(op + 4) = acc[ai][bj][m][1]; }
    }
};
struct EpiKV {
    static constexpr bool PERM = true;
    float* outk; float* outv; bf16_t* KP; bf16_t* VTP;
    __device__ __forceinline__ void operator()(f32x4 (&acc)[2][2][4][2], const Unit& u, int wr, int wc, int fr, int fq) const {
        const int row0 = u.pm * BM + wr * 64 + fr, l = u.pn >> 3, colL0 = (u.pn & 7) * BM + wc * 64 + 8 * fq;
        const bool isv = colL0 >= MW;
#pragma unroll
        for (int ai = 0; ai < 2; ++ai)
#pragma unroll
            for (int m = 0; m < 4; ++m) {
                const int row = row0 + ai * HALF + m * 16;
#pragma unroll
                for (int bj = 0; bj < 2; ++bj) {
                    const f32x4 v0 = acc[ai][bj][m][0], v1 = acc[ai][bj][m][1];
                    const int c = (colL0 + bj * CBJ) & (MW - 1);
                    float* op = (isv ? outv : outk) + (size_t)l * (512 * 1024) + (size_t)row * MW + c;
                    *(f32x4*)op = v0; *(f32x4*)(op + 4) = v1;
                    if (!isv) *(u32x4*)(KP + (size_t)l * (512 * 1024) + (size_t)row * MW + c) = pack8(v0, v1);
                    else {
                        const int b = row >> 8, key = row & 255, h = c >> 8, d = c & 255;
                        bf16_t* vp = VTP + ((size_t)((l * 2 + b) * 4 + h) * 256 + d) * 256 + key;
#pragma unroll
                        for (int j = 0; j < 4; ++j) { vp[(size_t)j * 256] = f2bf(v0[j]); vp[(size_t)(4 + j) * 256] = f2bf(v1[j]); }
                    }
                }
            }
    }
};
}

#define XB_TMO      128
#define XB_XCNT(j)  (256  + 64 * (j))
#define XB_XSUB(j)  (1280 + 64 * (j))
#define XB_XGEN(j)  (2304 + 64 * (j))
#define XB_TOP      3328
#define XB_TOPGEN   3392
#define XCD_BAR_WORDS 3456
#define XB_SPIN_CAP (1u << 18)
__device__ __forceinline__ unsigned xb_ld(unsigned* p)              { return __hip_atomic_load(p, __ATOMIC_RELAXED, __HIP_MEMORY_SCOPE_AGENT); }
__device__ __forceinline__ unsigned xb_add(unsigned* p, unsigned v) { return __hip_atomic_fetch_add(p, v, __ATOMIC_RELAXED, __HIP_MEMORY_SCOPE_AGENT); }
__device__ __forceinline__ unsigned xb_xcc_id() { return (unsigned)__builtin_amdgcn_s_getreg((3 << 11) | 20) & 0xFu; }
#define XB_SPIN(cond, bar) do { unsigned _sp = 0; while (cond) { __builtin_amdgcn_s_sleep(1); \
    if ((++_sp & 255u) == 0u) { if (xb_ld(&(bar)[XB_TMO])) break; if (_sp > XB_SPIN_CAP) { atomicAdd(&(bar)[XB_TMO], 1u); break; } } } } while (0)
struct XcdBarrier { unsigned* bar; unsigned x; volatile LAS unsigned* st; };
__device__ __forceinline__ XcdBarrier xcd_barrier_post(unsigned* bar, volatile LAS unsigned* st) {
    XcdBarrier b; b.bar = bar; b.x = xb_xcc_id(); b.st = st;
    if (threadIdx.x == 0) (void)xb_add(&bar[XB_XCNT(b.x)], 1u);
    return b;
}
__device__ __forceinline__ void xcd_barrier_complete(unsigned* bar, unsigned x, unsigned& nloc, unsigned& nx) {
    const unsigned G = gridDim.x * gridDim.y * gridDim.z;
    unsigned sum, cnt, mine, sp = 0u;
    for (;;) {
        sum = 0u; cnt = 0u; mine = 0u;
#pragma unroll
        for (unsigned j = 0; j < 16; ++j) { const unsigned c = xb_ld(&bar[XB_XCNT(j)]); sum += c; cnt += (c > 0u) ? 1u : 0u; mine = (j == x) ? c : mine; }
        if (sum == G) break;
        __builtin_amdgcn_s_sleep(1);
        if ((++sp & 255u) == 0u) { if (xb_ld(&bar[XB_TMO])) break; if (sp > XB_SPIN_CAP) { atomicAdd(&bar[XB_TMO], 1u); break; } }
    }
    nloc = mine > 0u ? mine : 1u; nx = cnt > 0u ? cnt : 1u;
}
__device__ __forceinline__ void xcd_barrier(const XcdBarrier& b) {
    asm volatile("s_waitcnt vmcnt(0)" ::: "memory");
    __syncthreads();
    if (threadIdx.x == 0) {
        unsigned* bar = b.bar;
        __builtin_amdgcn_s_waitcnt(0);
        unsigned nloc = b.st[0], nx = b.st[1];
        if (nloc == 0u) { xcd_barrier_complete(bar, b.x, nloc, nx); b.st[0] = nloc; b.st[1] = nx; }
        const unsigned old = xb_add(&bar[XB_XSUB(b.x)], 1u);
        const unsigned gen = old / nloc;
        if (old + 1u == (gen + 1u) * nloc) {
            __builtin_amdgcn_fence(__ATOMIC_RELEASE, "agent");
            asm volatile("s_waitcnt vmcnt(0)" ::: "memory");
            const unsigned og = xb_add(&bar[XB_TOP], 1u);
            const unsigned tg = og / nx;
            if (og + 1u == (tg + 1u) * nx) xb_add(&bar[XB_TOPGEN], 1u);
            else XB_SPIN(xb_ld(&bar[XB_TOPGEN]) == tg, bar);
            __builtin_amdgcn_fence(__ATOMIC_ACQUIRE, "agent");
            xb_add(&bar[XB_XGEN(b.x)], 1u);
            asm volatile("s_waitcnt vmcnt(0)" ::: "memory");
        } else {
            XB_SPIN(xb_ld(&bar[XB_XGEN(b.x)]) == gen, bar);
            __builtin_amdgcn_fence(__ATOMIC_ACQUIRE, "agent");
            asm volatile("s_waitcnt vmcnt(0)" ::: "memory");
        }
    }
    __syncthreads();
}

struct TItem { const float* W; bf16_t* WT; const float* scale; int K, N, r, nblk, noff, kind; const unsigned* cmax; int* csum; };
__device__ __forceinline__ void titem_load(const TItem& t, f32x4 (&x)[16], float (&sc)[16], int lane) {
    const int nblk = t.nblk, kb = t.r / nblk, nb = t.r - kb * nblk, k0 = 64 * kb, n0 = t.noff + 64 * nb, c = lane & 15, r = lane >> 4;
#pragma unroll
    for (int i = 0; i < 16; ++i) { const int kk = t.kind ? 16 * (i >> 2) + 4 * r + (i & 3) : 8 * (i >> 1) + 2 * r + (i & 1); x[i] = __builtin_nontemporal_load((const f32x4*)(t.W + (size_t)(k0 + kk) * t.N + n0 + 4 * c)); sc[i] = t.scale ? t.scale[k0 + kk] : 1.0f; }
}
__device__ __forceinline__ void titem_finish(const TItem& t, const f32x4 (&x)[16], const float (&sc)[16], LAS float* scr_f, int lane) {
    LAS unsigned* scr = (LAS unsigned*)scr_f;
    const int nblk = t.nblk, kb = t.r / nblk, nb = t.r - kb * nblk, k0 = 64 * kb, n0 = t.noff + 64 * nb, c = lane & 15, r = lane >> 4;
    if (t.kind) {
        float inv[4];
#pragma unroll
        for (int e = 0; e < 4; ++e) inv[e] = 127.0f / fmaxf(__uint_as_float(t.cmax[n0 - t.noff + 4 * c + e]), 1e-30f);
#pragma unroll
        for (int p = 0; p < 4; ++p)
#pragma unroll
            for (int e = 0; e < 4; ++e) {
                unsigned w = 0;
#pragma unroll
                for (int j = 0; j < 4; ++j) { const float v = __builtin_amdgcn_fmed3f(__builtin_rintf(x[4 * p + j][e] * sc[4 * p + j] * inv[e]), -127.f, 127.f); w |= ((unsigned)(int)v & 255u) << (8 * j); }
                scr[(4 * c + e) * 17 + 4 * p + r] = w;
            }
        LDS_WAIT(); asm volatile("" ::: "memory");
        const int q4 = lane & 3;
#pragma unroll
        for (int j = 0; j < 4; ++j) { const int n = (lane >> 2) + 16 * j; const LAS unsigned* s = scr + n * 17 + 4 * q4;
            u32x4 o; o.x = s[0]; o.y = s[1]; o.z = s[2]; o.w = s[3];
            *(u32x4*)((unsigned char*)t.WT + (size_t)(n0 - t.noff + n) * t.K + k0 + 16 * q4) = o;
            if (t.csum) {
                int cs = __builtin_amdgcn_sdot4((int)o.x, 0x01010101, 0, false); cs = __builtin_amdgcn_sdot4((int)o.y, 0x01010101, cs, false); cs = __builtin_amdgcn_sdot4((int)o.z, 0x01010101, cs, false); cs = __builtin_amdgcn_sdot4((int)o.w, 0x01010101, cs, false);
                cs += __shfl_xor(cs, 1); cs += __shfl_xor(cs, 2);
                if (q4 == 0) { atomicAdd(t.csum + n0 - t.noff + n, cs * 128); atomicAdd(t.csum + (1 + (k0 >> 10)) * DM + n0 - t.noff + n, cs * 128); }
            } }
        LDS_WAIT(); asm volatile("" ::: "memory");
        return;
    }
#pragma unroll
    for (int p = 0; p < 8; ++p)
#pragma unroll
        for (int e = 0; e < 4; ++e) scr[(4 * c + e) * 33 + 4 * p + r] = cvtpk(x[2 * p][e] * sc[2 * p], x[2 * p + 1][e] * sc[2 * p + 1]);
    LDS_WAIT(); asm volatile("" ::: "memory");
    const int q = lane & 7;
#pragma unroll
    for (int j = 0; j < 8; ++j) { const int n = (lane >> 3) + 8 * j; const LAS unsigned* s = scr + n * 33 + 4 * q;
        u32x4 o; o.x = s[0]; o.y = s[1]; o.z = s[2]; o.w = s[3];
        *(u32x4*)(t.WT + (size_t)(n0 + n) * t.K + k0 + 8 * q) = o; }
    LDS_WAIT(); asm volatile("" ::: "memory");
}
__device__ __forceinline__ void row_quant8(const f32x4 (&n0)[4], const f32x4 (&n1)[4], float mul, unsigned char* qrow, float* sa, int lane) {
    float am = 0.f;
#pragma unroll
    for (int j = 0; j < 4; ++j)
#pragma unroll
        for (int e = 0; e < 4; ++e) am = fmaxf(am, fmaxf(__builtin_fabsf(n0[j][e]), __builtin_fabsf(n1[j][e])));
#pragma unroll
    for (int o = 1; o < 64; o <<= 1) am = fmaxf(am, __shfl_xor(am, o));
    am *= mul;
    const float inv = am > 0.f ? 127.0f / am : 0.f, k = inv * mul;
#pragma unroll
    for (int j = 0; j < 4; ++j) {
        u32x2 w; w.x = 0; w.y = 0;
#pragma unroll
        for (int e = 0; e < 4; ++e) { const float a = __builtin_amdgcn_fmed3f(__builtin_rintf(n0[j][e] * k), -127.f, 127.f), b = __builtin_amdgcn_fmed3f(__builtin_rintf(n1[j][e] * k), -127.f, 127.f);
            w.x |= ((unsigned)(int)a & 255u) << (8 * e); w.y |= ((unsigned)(int)b & 255u) << (8 * e); }
        *(u32x2*)(qrow + j * 512 + lane * 8) = w;
    }
    if (lane == 0) *sa = am * (1.0f / 127.0f);
}

__device__ __forceinline__ float row_to_bf16_normed(const float* xrow, bf16_t* orow, int lane, unsigned char* qrow = nullptr, float* sa = nullptr) {
    f32x4 a[4], b[4]; float ss = 0.f;
#pragma unroll
    for (int j = 0; j < 4; ++j) {
        a[j] = *(const f32x4*)(xrow + j * 512 + lane * 8); b[j] = *(const f32x4*)(xrow + j * 512 + lane * 8 + 4);
        ss += (a[j][0] * a[j][0] + a[j][1] * a[j][1]) + (a[j][2] * a[j][2] + a[j][3] * a[j][3]) + (b[j][0] * b[j][0] + b[j][1] * b[j][1]) + (b[j][2] * b[j][2] + b[j][3] * b[j][3]);
    }
    const float ms = wave_sum(ss) * (1.0f / DM) + EPS, rs = __builtin_amdgcn_rsqf(ms);
#pragma unroll
    for (int j = 0; j < 4; ++j) *(u32x4*)(orow + j * 512 + lane * 8) = pack8(a[j] * rs, b[j] * rs);
    if (qrow) row_quant8(a, b, rs, qrow, sa, lane);
    return __builtin_sqrtf(ms);
}

struct Args { const float* in[30]; float* out; unsigned char* ws; int ph_lo, ph_hi; };
enum { I_XP = 0, I_XS, I_MEM, I_SLH, I_SLC, I_SSC, I_CK, I_CV, I_GMIXPRE, I_WIN, I_BGATE, I_LCW, I_LCB, I_LWA, I_LBA, I_LWI, I_LBI, I_LAM, I_WBL, I_SCW, I_WBC, I_GMEM, I_WKV, I_WBM, I_WOUT,
       I_GMIXPOST, I_GMLPPRE, I_WUP, I_WDN, I_GMLPPOST };
constexpr int NPH = 1 + 9 * DEPTH;
constexpr int CV_B = 7800;

constexpr int IT_IN = (DM / 64) * (INC / 64), IT_BR = (1024 / 64) * (DM / 64), IT_OUT = (DM / 64) * (DM / 64), IT_UP = (DM / 64) * (DFF / 64), IT_DN = (DFF / 64) * (DM / 64), IT_KV = IT_OUT;
constexpr int IT_LW = IT_IN + 3 * IT_BR + IT_OUT + IT_UP + IT_DN, IT_W = DEPTH * IT_LW, IT_KVA = DEPTH * IT_KV, IT_V = (MEMLEN / 64) * (MW / 64), IT_ALL = IT_W + IT_KVA;
template <bool FULL> __device__ __forceinline__ TItem decode_item(const Args& args, int it) {
    unsigned char* ws = args.ws; TItem t;
    if (FULL) if (it >= IT_W + IT_KVA) { const int v = it - IT_W - IT_KVA, mb = v / IT_V; t.W = args.in[I_CV] + (size_t)mb * MEMLEN * MW; t.K = MEMLEN; t.N = MW; t.nblk = MW / 64; t.noff = 0; t.kind = 0; t.cmax = nullptr; t.csum = nullptr; t.WT = (bf16_t*)(ws + WS_VTS) + (size_t)mb * MEMLEN * MW; t.scale = nullptr; t.r = v - mb * IT_V; return t; }
    if (FULL) if (it >= IT_W) { const int v = it - IT_W, l = v / IT_KV; t.W = args.in[I_WKV] + (size_t)l * DM * DM; t.K = DM; t.N = DM; t.nblk = DM / 64; t.noff = 0; t.kind = 0; t.cmax = nullptr; t.csum = nullptr; t.WT = (bf16_t*)(ws + WS_WKV + l * SZ_WOUT); t.scale = args.in[I_GMEM] + l * DM; t.r = v - l * IT_KV; return t; }
    const int l = it / IT_LW; int r = it - l * IT_LW;
    t.noff = 0; t.kind = 0; t.cmax = nullptr; t.csum = nullptr;
    if (r < IT_IN) {
        constexpr int IT_INB = (DM / 64) * (C_I8 / 64);
        const bool q = r >= IT_INB;
        t.W = args.in[I_WIN] + (size_t)l * DM * INC; t.K = DM; t.N = INC; t.nblk = q ? NI8 / 64 : C_I8 / 64; t.scale = args.in[I_GMIXPRE] + l * DM; t.r = q ? r - IT_INB : r;
        t.noff = q ? C_I8 : 0; t.kind = q ? 1 : 0; t.WT = (bf16_t*)(ws + WS_WIN + l * SZ_WIN + (q ? WQ_OFF : 0));
        t.cmax = (const unsigned*)(ws + WS_CTL) + CW_CMAX + l * CM_L;
        return t; } r -= IT_IN;
    if (r < 3 * IT_BR) { const int s = r / IT_BR; t.W = args.in[s == 0 ? I_WBL : (s == 1 ? I_WBC : I_WBM)] + (size_t)l * 1024 * DM; t.K = 1024; t.N = DM; t.nblk = DM / 64; t.WT = (bf16_t*)(ws + WS_WBR + (l * 3 + s) * SZ_WBR1); t.scale = nullptr; t.r = r - s * IT_BR; return t; } r -= 3 * IT_BR;
    if (r < IT_OUT) { t.W = args.in[I_WOUT] + (size_t)l * DM * DM; t.K = DM; t.N = DM; t.nblk = DM / 64; t.WT = (bf16_t*)(ws + WS_WOUT + l * SZ_WOUT); t.scale = nullptr; t.r = r; return t; } r -= IT_OUT;
    if (r < IT_UP) { t.W = args.in[I_WUP] + (size_t)l * DM * DFF; t.K = DM; t.N = DFF; t.nblk = DFF / 64; t.WT = (bf16_t*)(ws + WS_WUP + l * SZ_WUP); t.scale = args.in[I_GMLPPRE] + l * DM; t.r = r; t.kind = 1; t.cmax = (const unsigned*)(ws + WS_CTL) + CW_CMAX + l * CM_L + NI8; return t; } r -= IT_UP;
    t.W = args.in[I_WDN] + (size_t)l * DFF * DM; t.K = DFF; t.N = DM; t.nblk = DM / 64; t.WT = (bf16_t*)(ws + WS_WDN + l * SZ_WUP); t.scale = nullptr; t.r = r; t.kind = 1;
    t.cmax = (const unsigned*)(ws + WS_CTL) + CW_CMAX + l * CM_L + NI8 + DFF; t.csum = (int*)(ws + WS_CTL) + cw_csum9(l); return t;
}
template <bool FULL> __device__ __forceinline__ void conv_stream(const Args& args, LAS float* scr, int lane_in, int it0, int it1, int w, int nw, int jump_at = 0x7fffffff, int jump_by = 0) {
    int lane = lane_in; asm volatile("" : "+v"(lane));
    int it = it0 + w;
    if (it >= it1) return;
    TItem cur = decode_item<FULL>(args, it < jump_at ? it : it + jump_by); f32x4 xc[16]; float sc[16];
    titem_load(cur, xc, sc, lane);
    for (;;) {
        const int nit = it + nw; const bool more = nit < it1;
        TItem nxt = cur; f32x4 xn[16]; float sn[16];
        if (more) { nxt = decode_item<FULL>(args, nit < jump_at ? nit : nit + jump_by); titem_load(nxt, xn, sn, lane); }
        titem_finish(cur, xc, sc, scr, lane);
        if (!more) break;
#pragma unroll
        for (int i = 0; i < 16; ++i) { xc[i] = xn[i]; sc[i] = sn[i]; }
        cur = nxt; it = nit;
    }
}

template <bool FINAL, bool SMP>
__device__ __forceinline__ void lru_unit(const Args& args, int l, int p, int h, LAS unsigned char* lds, int wave, int lane) {
    asm volatile("" : "+v"(lane));
    unsigned char* ws = args.ws;
    const bf16_t* PROJ = (const bf16_t*)(ws + WS_PROJ);
    const int r16 = lane & 15, g = lane >> 4;
    const int b = SMP ? (p - 64) * 8 + wave : (p >> 5);
    const int t0 = SMP ? 0 : ((p & 31) * 256 + 32 * wave);
    const int R0 = p * 256 + 32 * wave;
    LAS float* WA = (LAS float*)lds; LAS float* WB = WA + 8 * 64; LAS float* HIN = WB + 8 * 64;
    u32x4 xr[2][2][4];
    f32x4 cwv[2][4][2], cbv[2][2];
    {
        const float* cw = args.in[I_LCW] + (size_t)l * 4 * LW; const float* cb = args.in[I_LCB] + (size_t)l * LW;
#pragma unroll
        for (int ks = 0; ks < 2; ++ks) {
            const int c0 = h * 64 + 32 * ks + 8 * g;
#pragma unroll
            for (int mt = 0; mt < 2; ++mt)
#pragma unroll
                for (int k = 0; k < 4; ++k) { const int rr = R0 + 16 * mt + r16 + k - 3; const bf16_t* src = PROJ + (size_t)(rr < 0 ? 0 : rr) * INC + C_LX + c0;
                    if (SMP && mt == 0 && k < 3) { const int ts = r16 + k - 3; const bf16_t* alt = (const bf16_t*)(ws + WS_SLCB) + ((size_t)(l * DBATCH + b) * 3 + (ts < 0 ? 3 + ts : 0)) * LW + c0; src = ts < 0 ? alt : src; }
                    xr[ks][mt][k] = *(const u32x4*)src; }
#pragma unroll
            for (int k = 0; k < 4; ++k) { cwv[ks][k][0] = *(const f32x4*)(cw + k * LW + c0); cwv[ks][k][1] = *(const f32x4*)(cw + k * LW + c0 + 4); }
            cbv[ks][0] = *(const f32x4*)(cb + c0); cbv[ks][1] = *(const f32x4*)(cb + c0 + 4);
        }
    }
    bf16x8 Af[2][2];
#pragma unroll
        for (int mt = 0; mt < 2; ++mt) {
            f32x4 u0 = cbv[0][0], u1 = cbv[0][1];
#pragma unroll
            for (int k = 0; k < 4; ++k) {
                const int ts = t0 + 16 * mt + r16 + k - 3;
                f32x4 x0, x1; unpack8(xr[0][mt][k], x0, x1);
                if (!SMP) { const float keep = ts < 0 ? 0.f : 1.f; x0 = x0 * keep; x1 = x1 * keep; }
                u0 += cwv[0][k][0] * x0; u1 += cwv[0][k][1] * x1;
            }
            Af[mt][0] = __builtin_bit_cast(bf16x8, pack8(u0, u1));
        }
    asm volatile("" ::: "memory");
    bf16x8 fa[4][2], fi[4][2];
    float bav[4], biv[4], lamv[4];
    {
        const bf16_t* WAT = (const bf16_t*)(ws + WS_WAT) + ((size_t)(l * LHEADS + h) * 64) * 64;
        const bf16_t* WIT = (const bf16_t*)(ws + WS_WIT) + ((size_t)(l * LHEADS + h) * 64) * 64;
        const float* ba = args.in[I_LBA] + (size_t)l * LW; const float* bi = args.in[I_LBI] + (size_t)l * LW; const float* c8t = (const float*)(ws + WS_PA) + (size_t)l * LW;
#pragma unroll
        for (int nt = 0; nt < 4; ++nt) {
#pragma unroll
            for (int ks = 0; ks < 2; ++ks) { const int n = 16 * nt + r16, k0 = 32 * ks + 8 * g; fa[nt][ks] = *(const bf16x8*)(WAT + n * 64 + k0); fi[nt][ks] = *(const bf16x8*)(WIT + n * 64 + k0); }
            const int ch = h * 64 + 16 * nt + r16; bav[nt] = ba[ch]; biv[nt] = bi[ch]; lamv[nt] = c8t[ch];
        }
    }
    asm volatile("" ::: "memory");
#pragma unroll
        for (int mt = 0; mt < 2; ++mt) {
            f32x4 u0 = cbv[1][0], u1 = cbv[1][1];
#pragma unroll
            for (int k = 0; k < 4; ++k) {
                const int ts = t0 + 16 * mt + r16 + k - 3;
                f32x4 x0, x1; unpack8(xr[1][mt][k], x0, x1);
                if (!SMP) { const float keep = ts < 0 ? 0.f : 1.f; x0 = x0 * keep; x1 = x1 * keep; }
                u0 += cwv[1][k][0] * x0; u1 += cwv[1][k][1] * x1;
            }
            Af[mt][1] = __builtin_bit_cast(bf16x8, pack8(u0, u1));
        }
    f32x4 Da[2][4], Di[2][4], Du[2][4];
#pragma unroll
    for (int nt = 0; nt < 4; ++nt) {
#pragma unroll
        for (int mt = 0; mt < 2; ++mt) { Da[mt][nt] = (f32x4){0.f, 0.f, 0.f, 0.f}; Di[mt][nt] = Da[mt][nt]; Du[mt][nt] = Da[mt][nt]; }
#pragma unroll
        for (int ks = 0; ks < 2; ++ks) {
            const int n = 16 * nt + r16, k0 = 32 * ks + 8 * g;
            bf16x8 id;
#pragma unroll
            for (int j = 0; j < 8; ++j) id[j] = (k0 + j == n) ? (short)0x3F80 : (short)0;
#pragma unroll
            for (int mt = 0; mt < 2; ++mt) {
                Da[mt][nt] = __builtin_amdgcn_mfma_f32_16x16x32_bf16(Af[mt][ks], fa[nt][ks], Da[mt][nt], 0, 0, 0);
                Di[mt][nt] = __builtin_amdgcn_mfma_f32_16x16x32_bf16(Af[mt][ks], fi[nt][ks], Di[mt][nt], 0, 0, 0);
                Du[mt][nt] = __builtin_amdgcn_mfma_f32_16x16x32_bf16(Af[mt][ks], id, Du[mt][nt], 0, 0, 0);
            }
        }
    }
    float totA[4], totB[4];
#pragma unroll
    for (int nt = 0; nt < 4; ++nt) {
        const float c8 = lamv[nt];
        float cA = 1.f, cB = 0.f;
#pragma unroll
        for (int mt = 0; mt < 2; ++mt) {
            float av[4], bv[4];
#pragma unroll
            for (int j = 0; j < 4; ++j) {
                const float r = fsigmoid(Da[mt][nt][j] + bav[nt]), ig = fsigmoid(Di[mt][nt][j] + biv[nt]);
                const float a = __builtin_amdgcn_exp2f(-LOG2E * c8 * r);
                av[j] = a; bv[j] = __builtin_amdgcn_sqrtf(fmaxf(1.0f - a * a, 0.f)) * (ig * Du[mt][nt][j]);
            }
            float pA[4], pB[4];
            pA[0] = av[0]; pB[0] = bv[0];
#pragma unroll
            for (int j = 1; j < 4; ++j) { pA[j] = pA[j - 1] * av[j]; pB[j] = av[j] * pB[j - 1] + bv[j]; }
            float tA[4], tB[4];
#pragma unroll
            for (int gg = 0; gg < 4; ++gg) { tA[gg] = __shfl(pA[3], r16 + 16 * gg); tB[gg] = __shfl(pB[3], r16 + 16 * gg); }
            float eA = cA, eB = cB;
#pragma unroll
            for (int gg = 0; gg < 3; ++gg) { const bool on = gg < g; const float nB = tA[gg] * eB + tB[gg], nA = eA * tA[gg]; eB = on ? nB : eB; eA = on ? nA : eA; }
#pragma unroll
            for (int j = 0; j < 4; ++j) { Da[mt][nt][j] = eA * pA[j]; Di[mt][nt][j] = pA[j] * eB + pB[j]; }
#pragma unroll
            for (int gg = 0; gg < 4; ++gg) { cB = tA[gg] * cB + tB[gg]; cA = cA * tA[gg]; }
        }
        totA[nt] = cA; totB[nt] = cB;
    }
    if (!FINAL) {
        if (g == 0) {
#pragma unroll
            for (int nt = 0; nt < 4; ++nt) { WA[wave * 64 + 16 * nt + r16] = totA[nt]; WB[wave * 64 + 16 * nt + r16] = totB[nt]; }
        }
        __syncthreads();
        if (wave == 0) {
            float A = 1.f, B = 0.f;
#pragma unroll
            for (int w = 0; w < 8; ++w) { const float a = WA[w * 64 + lane], bq = WB[w * 64 + lane]; B = a * B + bq; A = A * a; }
            float* PA = (float*)(ws + WS_PA); float* PB = (float*)(ws + WS_PB);
            const size_t o = ((size_t)b * 32 + (p & 31)) * LW + h * 64 + lane;
            PA[o] = A; PB[o] = B;
        }
        __syncthreads();
        return;
    }
    float hs[4];
    if (SMP) {
        const float* h0 = args.in[I_SLH] + ((size_t)l * DBATCH + b) * LW;
#pragma unroll
        for (int nt = 0; nt < 4; ++nt) hs[nt] = h0[h * 64 + 16 * nt + r16];
    } else {
        if (g == 0) {
#pragma unroll
            for (int nt = 0; nt < 4; ++nt) { WA[wave * 64 + 16 * nt + r16] = totA[nt]; WB[wave * 64 + 16 * nt + r16] = totB[nt]; }
        }
        __syncthreads();
        {
            typedef unsigned long long u64;
            const unsigned tag = (unsigned)l + 1u; const int np = p & 31;
            u64* gr = (u64*)(ws + WS_GRAN) + ((size_t)(b * 32) * LW + h * 64 + lane) * 2;
            if (wave == 0) {
                float A = 1.f, B = 0.f;
#pragma unroll
                for (int w = 0; w < 8; ++w) { const float a = WA[w * 64 + lane], bq = WB[w * 64 + lane]; B = a * B + bq; A = A * a; }
                __hip_atomic_store(gr + (size_t)np * LW * 2, ((u64)tag << 32) | __float_as_uint(A), __ATOMIC_RELAXED, __HIP_MEMORY_SCOPE_AGENT);
                __hip_atomic_store(gr + (size_t)np * LW * 2 + 1, ((u64)tag << 32) | __float_as_uint(B), __ATOMIC_RELAXED, __HIP_MEMORY_SCOPE_AGENT);
            }
            float pA = 1.f, pB = 0.f;
            if (4 * wave < np) {
                u64 va[4], vb[4]; unsigned spins = 0;
                for (;;) {
                    bool ok = true;
#pragma unroll
                    for (int k = 0; k < 4; ++k) { const int q = (4 * wave + k < np) ? 4 * wave + k : 4 * wave;
                        va[k] = __hip_atomic_load(gr + (size_t)q * LW * 2, __ATOMIC_RELAXED, __HIP_MEMORY_SCOPE_AGENT); vb[k] = __hip_atomic_load(gr + (size_t)q * LW * 2 + 1, __ATOMIC_RELAXED, __HIP_MEMORY_SCOPE_AGENT); }
#pragma unroll
                    for (int k = 0; k < 4; ++k) ok = ok && (unsigned)(va[k] >> 32) == tag && (unsigned)(vb[k] >> 32) == tag;
                    if (__all(ok) || ++spins > (1u << 16)) break;
                    __builtin_amdgcn_s_sleep(2);
                }
#pragma unroll
                for (int k = 0; k < 4; ++k) if (4 * wave + k < np) { const float a = __uint_as_float((unsigned)va[k]), bq = __uint_as_float((unsigned)vb[k]); pB = a * pB + bq; pA = pA * a; }
            }
            HIN[wave * 64 + lane] = pA; HIN[512 + wave * 64 + lane] = pB;
        }
        __syncthreads();
#pragma unroll
        for (int nt = 0; nt < 4; ++nt) {
            const int c = 16 * nt + r16; float hv = 0.f;
#pragma unroll
            for (int w = 0; w < 8; ++w) hv = HIN[w * 64 + c] * hv + HIN[512 + w * 64 + c];
#pragma unroll
            for (int w = 0; w < 7; ++w) { const float nv = WA[w * 64 + c] * hv + WB[w * 64 + c]; hv = w < wave ? nv : hv; }
            hs[nt] = hv;
        }
    }
    bf16_t gt[2][4][4];
    const unsigned go0 = (unsigned)(((R0 + 4 * g) * INC + C_LG + h * 64 + r16) * 2);
    const unsigned so0 = (unsigned)(((R0 + 4 * g) * LW + h * 64 + r16) * 2);
    asm volatile("" ::: "memory");
    if (FINAL) {
#pragma unroll
        for (int nt = 0; nt < 4; ++nt)
#pragma unroll
            for (int mt = 0; mt < 2; ++mt)
#pragma unroll
                for (int j = 0; j < 4; ++j) gt[mt][nt][j] = *(const bf16_t*)((const char*)PROJ + (go0 + (unsigned)((16 * mt + j) * (INC * 2) + 32 * nt)));
    }
    bf16_t* ALRU = (bf16_t*)(ws + WS_ABR);
    const bool lastw = SMP || ((p & 31) == 31 && wave == 7);
    float* hout = SMP ? args.out + O_SLH + ((size_t)l * DBATCH + b) * LW : args.out + O_PLH + ((size_t)l * NBATCH + b) * LW;
#pragma unroll
    for (int nt = 0; nt < 4; ++nt) {
        const int ch = h * 64 + 16 * nt + r16;
#pragma unroll
        for (int mt = 0; mt < 2; ++mt)
#pragma unroll
            for (int j = 0; j < 4; ++j) {
                const float hv = Da[mt][nt][j] * hs[nt] + Di[mt][nt][j];
                *(bf16_t*)((char*)ALRU + (so0 + (unsigned)((16 * mt + j) * (LW * 2) + 32 * nt))) = f2bf(hv * bf1(gt[mt][nt][j]));
                if (lastw && mt == 1 && j == 3 && g == 3) hout[ch] = hv;
            }
    }
    if (!SMP) __syncthreads();
}

__device__ __forceinline__ void sconv_item(const Args& args, int l, int item, int lane) {
    asm volatile("" : "+v"(lane));
    unsigned char* ws = args.ws;
    const bf16_t* PROJ = (const bf16_t*)(ws + WS_PROJ); bf16_t* ACONV = (bf16_t*)(ws + WS_ABR + SZ_ABR1);
    const int tb = item >> 1, c0 = (item & 1) * 512 + lane * 8, row0 = tb * 8;
    const bool smp = row0 >= MP;
    const int b = smp ? (row0 - MP) / DSEQ : row0 / SEQ, t0 = smp ? (row0 - MP) % DSEQ : row0 % SEQ, T = smp ? DSEQ : SEQ;
    const float* cw = args.in[I_SCW] + (size_t)l * 3 * LW + c0;
    f32x4 w[3][2];
#pragma unroll
    for (int k = 0; k < 3; ++k) { w[k][0] = *(const f32x4*)(cw + k * LW); w[k][1] = *(const f32x4*)(cw + k * LW + 4); }
    f32x4 zm2[2], zm1[2];
    if (t0 > 0) {
        f32x4 a0, a1, b0, b1;
        unpack8(*(const u32x4*)(PROJ + (size_t)(row0 - 2) * INC + C_SC + c0), a0, a1); unpack8(*(const u32x4*)(PROJ + (size_t)(row0 - 2) * INC + C_SH + c0), b0, b1); zm2[0] = a0 * b0; zm2[1] = a1 * b1;
        unpack8(*(const u32x4*)(PROJ + (size_t)(row0 - 1) * INC + C_SC + c0), a0, a1); unpack8(*(const u32x4*)(PROJ + (size_t)(row0 - 1) * INC + C_SH + c0), b0, b1); zm1[0] = a0 * b0; zm1[1] = a1 * b1;
    } else if (smp) {
        const float* sb = args.in[I_SSC] + ((size_t)l * DBATCH + b) * 2 * LW + c0;
        zm2[0] = *(const f32x4*)sb; zm2[1] = *(const f32x4*)(sb + 4); zm1[0] = *(const f32x4*)(sb + LW); zm1[1] = *(const f32x4*)(sb + LW + 4);
    } else { zm2[0] = (f32x4){0.f, 0.f, 0.f, 0.f}; zm2[1] = zm2[0]; zm1[0] = zm2[0]; zm1[1] = zm2[0]; }
#pragma unroll
    for (int i = 0; i < 8; ++i) {
        const bf16_t* pr = PROJ + (size_t)(row0 + i) * INC + c0;
        f32x4 a0, a1, b0, b1, s0, s1;
        unpack8(*(const u32x4*)(pr + C_SC), a0, a1); unpack8(*(const u32x4*)(pr + C_SH), b0, b1); unpack8(*(const u32x4*)(pr + C_SB), s0, s1);
        const f32x4 z0 = a0 * b0, z1 = a1 * b1;
        const f32x4 cv0 = w[0][0] * zm2[0] + w[1][0] * zm1[0] + w[2][0] * z0, cv1 = w[0][1] * zm2[1] + w[1][1] * zm1[1] + w[2][1] * z1;
        *(u32x4*)(ACONV + (size_t)(row0 + i) * LW + c0) = pack8(s0 * cv0, s1 * cv1);
        zm2[0] = zm1[0]; zm2[1] = zm1[1]; zm1[0] = z0; zm1[1] = z1;
    }
    if (t0 + 8 == T) {
        float* so = smp ? args.out + O_SSC + ((size_t)l * DBATCH + b) * 2 * LW + c0 : args.out + O_PSC + ((size_t)l * NBATCH + b) * 2 * LW + c0;
        *(f32x4*)so = zm2[0]; *(f32x4*)(so + 4) = zm2[1]; *(f32x4*)(so + LW) = zm1[0]; *(f32x4*)(so + LW + 4) = zm1[1];
        float* lo = smp ? args.out + O_SLC + ((size_t)l * DBATCH + b) * 3 * LW + c0 : args.out + O_PLC + ((size_t)l * NBATCH + b) * 3 * LW + c0;
#pragma unroll
        for (int k = 0; k < 3; ++k) { f32x4 x0, x1; unpack8(*(const u32x4*)(PROJ + (size_t)(row0 + 5 + k) * INC + C_LX + c0), x0, x1); *(f32x4*)(lo + k * LW) = x0; *(f32x4*)(lo + k * LW + 4) = x1; }
    }
}

__device__ __forceinline__ int crow(int r, int hi) { return (r & 3) + 8 * (r >> 2) + 4 * hi; }
constexpr int ATT_LDS = 8192;
__device__ __forceinline__ void attn_wg_unit(const Args& args, int l, int u, LAS unsigned char* lds, int tid_in) {
    int tid = tid_in; asm volatile("" : "+v"(tid));
    unsigned char* ws = args.ws;
    const bf16_t* PROJ = (const bf16_t*)(ws + WS_PROJ); bf16_t* AMEM = (bf16_t*)(ws + WS_ABR + 2 * SZ_ABR1);
    const int lane = tid & 63, wave = __builtin_amdgcn_readfirstlane(tid >> 6), r32 = lane & 31, hh = lane >> 5;
    const int panel = u >> 2, head = u & 3, b = panel >> 5, row0 = panel * 256 + 32 * wave;
    const bf16_t* Kb = (const bf16_t*)(ws + WS_KP) + (size_t)(l * NBATCH + b) * MEMLEN * MW + head * MHD;
    const bf16_t* Vt = (const bf16_t*)(ws + WS_VTP) + (size_t)((l * NBATCH + b) * MHEADS + head) * MHD * MEMLEN;
    LAS unsigned char* buf = lds + ATT_LDS;
    const int kkey = tid & 15, kdch = tid >> 4;
    const bf16_t* ksrc = Kb + (size_t)kkey * MW + 8 * kdch;
    const int kdst = (kdch >> 1) * 1024 + (kkey + 32 * (kdch & 1)) * 16;
    const int vd = tid >> 1, vs = tid & 1;
    const bf16_t* vsrc = Vt + (size_t)vd * MEMLEN + 16 * vs;
    const int vdst = ((vd >> 5) * 2 + vs) * 1024 + (vd & 31) * 16;
    bf16x8 qf[16];
    { const bf16_t* qp = PROJ + (size_t)(row0 + r32) * INC + C_Q + head * MHD + 8 * hh;
#pragma unroll
      for (int ks = 0; ks < 16; ++ks) qf[ks] = *(const bf16x8*)(qp + 16 * ks); }
    u32x4 s0, s1;
    s0 = *(const u32x4*)(ksrc); s1 = *(const u32x4*)(ksrc + (size_t)16 * MW);
    *(LAS u32x4*)(buf + kdst) = s0; *(LAS u32x4*)(buf + kdst + 256) = s1;
    __syncthreads();
    f32x16 st[8];
#pragma unroll
    for (int kt = 0; kt < 8; ++kt) {
        if (kt < 7) { s0 = *(const u32x4*)(ksrc + (size_t)(32 * (kt + 1)) * MW); s1 = *(const u32x4*)(ksrc + (size_t)(32 * (kt + 1) + 16) * MW); }
        else { s0 = *(const u32x4*)(vsrc); s1 = *(const u32x4*)(vsrc + 8); }
        const LAS unsigned char* cb = buf + (kt & 1) * 16384 + lane * 16;
        f32x16 acc;
#pragma unroll
        for (int i = 0; i < 16; ++i) acc[i] = 0.f;
#pragma unroll
        for (int ks = 0; ks < 16; ++ks) { const bf16x8 kf = *(const LAS bf16x8*)(cb + ks * 1024); acc = __builtin_amdgcn_mfma_f32_32x32x16_bf16(kf, qf[ks], acc, 0, 0, 0); }
        st[kt] = acc;
        LAS unsigned char* nb = buf + ((kt + 1) & 1) * 16384;
        if (kt < 7) { *(LAS u32x4*)(nb + kdst) = s0; *(LAS u32x4*)(nb + kdst + 256) = s1; }
        else { *(LAS u32x4*)(nb + vdst) = (u32x4){s0.x, s0.y, s1.x, s1.y}; *(LAS u32x4*)(nb + vdst + 512) = (u32x4){s0.z, s0.w, s1.z, s1.w}; }
        __syncthreads();
    }
    float mx = st[0][0];
#pragma unroll
    for (int kt = 0; kt < 8; ++kt)
#pragma unroll
        for (int i = 0; i < 16; ++i) mx = fmaxf(mx, st[kt][i]);
    mx = fmaxf(mx, __shfl_xor(mx, 32));
    float sum = 0.f;
    bf16x8 pf[8][2];
#pragma unroll
    for (int kt = 0; kt < 8; ++kt) {
#pragma unroll
        for (int i = 0; i < 16; ++i) { const float e = __builtin_amdgcn_exp2f(st[kt][i] - mx); st[kt][i] = e; sum += e; }
#pragma unroll
        for (int s = 0; s < 2; ++s) { u32x4 w; w.x = cvtpk(st[kt][8 * s + 0], st[kt][8 * s + 1]); w.y = cvtpk(st[kt][8 * s + 2], st[kt][8 * s + 3]); w.z = cvtpk(st[kt][8 * s + 4], st[kt][8 * s + 5]); w.w = cvtpk(st[kt][8 * s + 6], st[kt][8 * s + 7]);
            pf[kt][s] = __builtin_bit_cast(bf16x8, w); }
    }
    sum += __shfl_xor(sum, 32);
    const float inv = __builtin_amdgcn_rcpf(sum);
    f32x16 ot[8];
#pragma unroll
    for (int dt = 0; dt < 8; ++dt)
#pragma unroll
        for (int i = 0; i < 16; ++i) ot[dt][i] = 0.f;
#pragma unroll
    for (int kt = 0; kt < 8; ++kt) {
        if (kt < 7) { s0 = *(const u32x4*)(vsrc + 32 * (kt + 1)); s1 = *(const u32x4*)(vsrc + 32 * (kt + 1) + 8); }
        const LAS unsigned char* cb = buf + (kt & 1) * 16384 + lane * 16;
#pragma unroll
        for (int dt = 0; dt < 8; ++dt)
#pragma unroll
            for (int s = 0; s < 2; ++s) { const bf16x8 vf = *(const LAS bf16x8*)(cb + (dt * 2 + s) * 1024); ot[dt] = __builtin_amdgcn_mfma_f32_32x32x16_bf16(vf, pf[kt][s], ot[dt], 0, 0, 0); }
        if (kt < 7) {
            LAS unsigned char* nb = buf + ((kt + 1) & 1) * 16384;
            *(LAS u32x4*)(nb + vdst) = (u32x4){s0.x, s0.y, s1.x, s1.y}; *(LAS u32x4*)(nb + vdst + 512) = (u32x4){s0.z, s0.w, s1.z, s1.w};
        }
        __syncthreads();
    }
    bf16_t* op = AMEM + (size_t)(row0 + r32) * MW + head * MHD;
#pragma unroll
    for (int dt = 0; dt < 8; ++dt)
#pragma unroll
        for (int ig = 0; ig < 4; ++ig) {
            u32x2 w; w.x = cvtpk(ot[dt][4 * ig] * inv, ot[dt][4 * ig + 1] * inv); w.y = cvtpk(ot[dt][4 * ig + 2] * inv, ot[dt][4 * ig + 3] * inv);
            *(u32x2*)(op + 32 * dt + 8 * ig + 4 * hh) = w;
        }
}

__device__ __forceinline__ void attn_sample_unit(const Args& args, int l, int u, LAS unsigned char* lds, int tid_in) {
    int tid = tid_in; asm volatile("" : "+v"(tid));
    unsigned char* ws = args.ws;
    const bf16_t* PROJ = (const bf16_t*)(ws + WS_PROJ); bf16_t* AMEM = (bf16_t*)(ws + WS_ABR + 2 * SZ_ABR1);
    const int lane = tid & 63, wave = __builtin_amdgcn_readfirstlane(tid >> 6), r32 = lane & 31, hh = lane >> 5;
    const int head = u >> 5, b = u & 31, row0 = MP + b * DSEQ;
    const float* Kc = args.in[I_CK] + (size_t)(l * DBATCH + b) * MEMLEN * MW + head * MHD;
    const float* Vc = args.in[I_CV] + (size_t)(l * DBATCH + b) * MEMLEN * MW + head * MHD;
    LAS float* RMX = (LAS float*)(lds + ATT_LDS); LAS float* RSM = RMX + 256; LAS unsigned char* PB = lds + ATT_LDS + 4096;
    bf16x8 qf[16], kf[16];
    { const bf16_t* qp = PROJ + (size_t)(row0 + r32) * INC + C_Q + head * MHD + 8 * hh; const float* kp = Kc + (size_t)(32 * wave + r32) * MW + 8 * hh;
#pragma unroll
      for (int ks = 0; ks < 16; ++ks) { qf[ks] = *(const bf16x8*)(qp + 16 * ks); kf[ks] = __builtin_bit_cast(bf16x8, pack8(*(const f32x4*)(kp + 16 * ks), *(const f32x4*)(kp + 16 * ks + 4))); } }
    f32x16 acc;
#pragma unroll
    for (int i = 0; i < 16; ++i) acc[i] = 0.f;
#pragma unroll
    for (int ks = 0; ks < 16; ++ks) acc = __builtin_amdgcn_mfma_f32_32x32x16_bf16(kf[ks], qf[ks], acc, 0, 0, 0);
    float m = acc[0];
#pragma unroll
    for (int i = 1; i < 16; ++i) m = fmaxf(m, acc[i]);
    m = fmaxf(m, __shfl_xor(m, 32));
    if (hh == 0) RMX[wave * 32 + r32] = m;
    __syncthreads();
    float gm = RMX[r32];
#pragma unroll
    for (int w = 1; w < 8; ++w) gm = fmaxf(gm, RMX[w * 32 + r32]);
    float sm = 0.f;
#pragma unroll
    for (int i = 0; i < 16; ++i) { acc[i] = __builtin_amdgcn_exp2f(acc[i] - gm); sm += acc[i]; }
    sm += __shfl_xor(sm, 32);
    if (hh == 0) RSM[wave * 32 + r32] = sm;
#pragma unroll
    for (int s = 0; s < 2; ++s) { u32x4 w; w.x = cvtpk(acc[8 * s + 0], acc[8 * s + 1]); w.y = cvtpk(acc[8 * s + 2], acc[8 * s + 3]); w.z = cvtpk(acc[8 * s + 4], acc[8 * s + 5]); w.w = cvtpk(acc[8 * s + 6], acc[8 * s + 7]);
        *(LAS u32x4*)(PB + (wave * 2 + s) * 1024 + lane * 16) = w; }
    __syncthreads();
    float tot = 0.f;
#pragma unroll
    for (int w = 0; w < 8; ++w) tot += RSM[w * 32 + r32];
    const float inv = __builtin_amdgcn_rcpf(tot);
    f32x16 o;
#pragma unroll
    for (int i = 0; i < 16; ++i) o[i] = 0.f;
#pragma unroll
    for (int c = 0; c < 16; ++c) {
        const float* vp = Vc + (size_t)(16 * c + 4 * hh) * MW + 32 * wave + r32;
        u32x4 vw; vw.x = cvtpk(vp[0], vp[MW]); vw.y = cvtpk(vp[2 * MW], vp[3 * MW]); vw.z = cvtpk(vp[8 * MW], vp[9 * MW]); vw.w = cvtpk(vp[10 * MW], vp[11 * MW]);
        const bf16x8 vf = __builtin_bit_cast(bf16x8, vw);
        const bf16x8 pfr = *(const LAS bf16x8*)(PB + c * 1024 + lane * 16);
        o = __builtin_amdgcn_mfma_f32_32x32x16_bf16(vf, pfr, o, 0, 0, 0);
    }
    bf16_t* op = AMEM + (size_t)(row0 + r32) * MW + head * MHD + 32 * wave;
#pragma unroll
    for (int ig = 0; ig < 4; ++ig) {
        u32x2 w; w.x = cvtpk(o[4 * ig] * inv, o[4 * ig + 1] * inv); w.y = cvtpk(o[4 * ig + 2] * inv, o[4 * ig + 3] * inv);
        *(u32x2*)(op + 8 * ig + 4 * hh) = w;
    }
    __syncthreads();
}

template <int NR>
__device__ __forceinline__ void norm_prompt_rows(const Args& args, const float* gpost, bool last, bool want_q, const int (&rows)[NR], int lane) {
    unsigned char* ws = args.ws;
    const bf16_t* Y = (const bf16_t*)(ws + WS_Y); const float* SSY = (const float*)(ws + WS_SSY); bf16_t* XB = (bf16_t*)(ws + WS_XB); float* RS = (float*)(ws + WS_SSX);
    float part[NR], xs[NR], rstd[NR], ss[NR]; u32x4 xq[NR][4], yq[NR][4];
#pragma unroll
    for (int r = 0; r < NR; ++r) {
        part[r] = lane < 32 ? SSY[(size_t)rows[r] * 32 + lane] : 0.f; xs[r] = RS[rows[r]];
#pragma unroll
        for (int j = 0; j < 4; ++j) { xq[r][j] = __builtin_nontemporal_load((const u32x4*)(XB + (size_t)rows[r] * DM + j * 512 + lane * 8)); yq[r][j] = __builtin_nontemporal_load((const u32x4*)(Y + (size_t)rows[r] * DM + j * 512 + lane * 8)); }
    }
#pragma unroll
    for (int o = 1; o < 64; o <<= 1)
#pragma unroll
        for (int r = 0; r < NR; ++r) part[r] += __shfl_xor(part[r], o);
#pragma unroll
    for (int r = 0; r < NR; ++r) { rstd[r] = __builtin_amdgcn_rsqf(part[r] * (1.0f / DM) + EPS); ss[r] = 0.f; }
    f32x4 n0[NR][4], n1[NR][4];
#pragma unroll
    for (int j = 0; j < 4; ++j) {
        const int c = j * 512 + lane * 8;
        const f32x4 g0 = *(const f32x4*)(gpost + c), g1 = *(const f32x4*)(gpost + c + 4);
#pragma unroll
        for (int r = 0; r < NR; ++r) {
            f32x4 x0, x1, y0, y1; unpack8(xq[r][j], x0, x1); unpack8(yq[r][j], y0, y1);
            const f32x4 a = x0 * xs[r] + y0 * rstd[r] * g0, b = x1 * xs[r] + y1 * rstd[r] * g1;
            n0[r][j] = a; n1[r][j] = b;
            ss[r] += (a[0] * a[0] + a[1] * a[1]) + (a[2] * a[2] + a[3] * a[3]) + (b[0] * b[0] + b[1] * b[1]) + (b[2] * b[2] + b[3] * b[3]);
        }
    }
    if (last) {
#pragma unroll
        for (int r = 0; r < NR; ++r) { float* xo = args.out + (size_t)rows[r] * DM;
#pragma unroll
            for (int j = 0; j < 4; ++j) { *(f32x4*)(xo + j * 512 + lane * 8) = n0[r][j]; *(f32x4*)(xo + j * 512 + lane * 8 + 4) = n1[r][j]; } }
    } else {
#pragma unroll
        for (int o = 1; o < 64; o <<= 1)
#pragma unroll
            for (int r = 0; r < NR; ++r) ss[r] += __shfl_xor(ss[r], o);
#pragma unroll
        for (int r = 0; r < NR; ++r) {
            const float ms = ss[r] * (1.0f / DM) + EPS, rs2 = __builtin_amdgcn_rsqf(ms);
#pragma unroll
            for (int j = 0; j < 4; ++j) *(u32x4*)(XB + (size_t)rows[r] * DM + j * 512 + lane * 8) = pack8(n0[r][j] * rs2, n1[r][j] * rs2);
            if (lane == 0) RS[rows[r]] = __builtin_sqrtf(ms);
            if (want_q) row_quant8(n0[r], n1[r], rs2, ws + WS_XQ + (size_t)rows[r] * DM, (float*)(ws + WS_SA) + rows[r], lane);
        }
    }
}
__device__ __forceinline__ void norm_rows(const Args& args, const float* gpost, const float* yp, bool ybf, bool last, bool want_q, int gw, int ngw, int lane) {
    asm volatile("" : "+v"(lane)); asm volatile("" : "+s"(gw));
    unsigned char* ws = args.ws;
    bf16_t* XB = (bf16_t*)(ws + WS_XB); float* RS = (float*)(ws + WS_SSX);
    int row = gw;
    for (; row + ngw < MP; row += 2 * ngw) { const int rows[2] = {row, row + ngw}; norm_prompt_rows<2>(args, gpost, last, want_q, rows, lane); }
    for (; row < MP; row += ngw) { const int rows[1] = {row}; norm_prompt_rows<1>(args, gpost, last, want_q, rows, lane); }
    for (; row < MT; row += ngw) {
        f32x4 ya[4], yb[4];
        const float xs = RS[row];
        u32x4 xq[4];
#pragma unroll
        for (int j = 0; j < 4; ++j) xq[j] = *(const u32x4*)(XB + (size_t)row * DM + j * 512 + lane * 8);
        float sq = 0.f;
#pragma unroll
        for (int j = 0; j < 4; ++j) {
            f32x4 a, b;
            if (ybf) {
                const bf16_t* pp = (const bf16_t*)yp + (size_t)(row - MP) * DM + j * 512 + lane * 8;
                u32x4 pv[8];
#pragma unroll
                for (int s = 0; s < 8; ++s) pv[s] = *(const u32x4*)(pp + (size_t)s * MS * DM);
                unpack8(pv[0], a, b);
#pragma unroll
                for (int s = 1; s < 8; ++s) { f32x4 a2, b2; unpack8(pv[s], a2, b2); a += a2; b += b2; }
            } else {
                const float* pp = yp + (size_t)(row - MP) * DM + j * 512 + lane * 8;
                a = *(const f32x4*)pp; b = *(const f32x4*)(pp + 4);
#pragma unroll
                for (int s = 1; s < 8; ++s) { a += *(const f32x4*)(pp + (size_t)s * MS * DM); b += *(const f32x4*)(pp + (size_t)s * MS * DM + 4); }
            }
            ya[j] = a; yb[j] = b;
            sq += (a[0] * a[0] + a[1] * a[1]) + (a[2] * a[2] + a[3] * a[3]) + (b[0] * b[0] + b[1] * b[1]) + (b[2] * b[2] + b[3] * b[3]);
        }
        const float rstd = __builtin_amdgcn_rsqf(wave_sum(sq) * (1.0f / DM) + EPS);
        float ss = 0.f; f32x4 n0[4], n1[4];
#pragma unroll
        for (int j = 0; j < 4; ++j) {
            const int c = j * 512 + lane * 8;
            f32x4 x0, x1; unpack8(xq[j], x0, x1);
            const f32x4 g0 = *(const f32x4*)(gpost + c), g1 = *(const f32x4*)(gpost + c + 4);
            n0[j] = x0 * xs + ya[j] * rstd * g0; n1[j] = x1 * xs + yb[j] * rstd * g1;
            ss += (n0[j][0] * n0[j][0] + n0[j][1] * n0[j][1]) + (n0[j][2] * n0[j][2] + n0[j][3] * n0[j][3]) + (n1[j][0] * n1[j][0] + n1[j][1] * n1[j][1]) + (n1[j][2] * n1[j][2] + n1[j][3] * n1[j][3]);
        }
        if (last) {
            float* xo = args.out + (size_t)row * DM;
#pragma unroll
            for (int j = 0; j < 4; ++j) { *(f32x4*)(xo + j * 512 + lane * 8) = n0[j]; *(f32x4*)(xo + j * 512 + lane * 8 + 4) = n1[j]; }
        } else {
            const float ms = wave_sum(ss) * (1.0f / DM) + EPS, rs2 = __builtin_amdgcn_rsqf(ms);
#pragma unroll
            for (int j = 0; j < 4; ++j) *(u32x4*)(XB + (size_t)row * DM + j * 512 + lane * 8) = pack8(n0[j] * rs2, n1[j] * rs2);
            if (lane == 0) RS[row] = __builtin_sqrtf(ms);
            if (want_q) row_quant8(n0, n1, rs2, ws + WS_XQ + (size_t)row * DM, (float*)(ws + WS_SA) + row, lane);
        }
    }
}

__global__ void __launch_bounds__(512, 2) mk_fwd(Args args) {
    extern __shared__ __attribute__((aligned(16))) unsigned char lds_raw[];
    LAS unsigned char* lds = (LAS unsigned char*)lds_raw;
    volatile LAS unsigned* MISC = (volatile LAS unsigned*)(lds + MISC_OFF);
    const int tid = threadIdx.x, lane = tid & 63, wave = __builtin_amdgcn_readfirstlane(tid >> 6);
    const int G = gridDim.x, bx = blockIdx.x;
    const int vcu = (G % 8 == 0) ? (bx % 8) * (G / 8) + bx / 8 : bx;
    const int gw = vcu * 8 + wave, ngw = G * 8;
    unsigned char* ws = args.ws;
    if (tid < 64) MISC[tid] = 0u;
    __syncthreads();
    XcdBarrier bar; bar.bar = (unsigned*)(ws + WS_CTL) + 4096; bar.x = 0; bar.st = MISC + 8;
    if (!MK_MULTI) bar = xcd_barrier_post((unsigned*)(ws + WS_CTL) + 4096, MISC + 8);
    const int lo = args.ph_lo, hi = args.ph_hi;
#define IN(k) (lo <= (k) && (k) < hi)
#define SEAM(k) do { if (IN(k) && IN((k) + 1)) for (int rr = 0; rr < DUP_BAR; ++rr) xcd_barrier(bar); } while (0)

    if (IN(0)) for (int rr = 0; rr < DUP_PRO; ++rr) {
        LAS float* scr = (LAS float*)(lds + wave * 16384);
        for (int t = gw; t < DEPTH * 60 * 16; t += ngw) {
            const int lr = t / (60 * 16), l = DEPTH - 1 - lr, r_ = t - lr * (60 * 16), strip = r_ >> 4, kb = r_ & 15;
            const bool up = strip >= 28; const int c0 = (up ? strip - 28 : strip) * 256 + 4 * lane, pitch = up ? DFF : INC;
            const float* wp = (up ? args.in[I_WUP] + (size_t)l * DM * DFF : args.in[I_WIN] + (size_t)l * DM * INC + C_I8) + (size_t)(kb * 128) * pitch + c0;
            const float* gp = (up ? args.in[I_GMLPPRE] : args.in[I_GMIXPRE]) + l * DM + kb * 128;
            f32x4 m = (f32x4){0.f, 0.f, 0.f, 0.f};
#pragma unroll 16
            for (int k = 0; k < 128; ++k) { const f32x4 v = *(const f32x4*)(wp + (size_t)k * pitch); const float g_ = __builtin_fabsf(gp[k]);
                m[0] = fmaxf(m[0], __builtin_fabsf(v[0]) * g_); m[1] = fmaxf(m[1], __builtin_fabsf(v[1]) * g_); m[2] = fmaxf(m[2], __builtin_fabsf(v[2]) * g_); m[3] = fmaxf(m[3], __builtin_fabsf(v[3]) * g_); }
            unsigned* cm = (unsigned*)(ws + WS_CTL) + CW_CMAX + l * CM_L + (up ? NI8 : 0) + c0;
#pragma unroll
            for (int e = 0; e < 4; ++e) atomicMax(cm + e, __float_as_uint(m[e]));
        }
        for (int t = gw; t < DEPTH * 8 * 64; t += ngw) {
            const int l = DEPTH - 1 - (t >> 9), r_ = t & 511, strip = r_ >> 6, kb = r_ & 63, c0 = strip * 256 + 4 * lane;
            const float* wp = args.in[I_WDN] + (size_t)l * DFF * DM + (size_t)(kb * 128) * DM + c0;
            f32x4 m = (f32x4){0.f, 0.f, 0.f, 0.f};
#pragma unroll 16
            for (int k = 0; k < 128; ++k) { const f32x4 v = *(const f32x4*)(wp + (size_t)k * DM);
                m[0] = fmaxf(m[0], __builtin_fabsf(v[0])); m[1] = fmaxf(m[1], __builtin_fabsf(v[1])); m[2] = fmaxf(m[2], __builtin_fabsf(v[2])); m[3] = fmaxf(m[3], __builtin_fabsf(v[3])); }
            unsigned* cm = (unsigned*)(ws + WS_CTL) + CW_CMAX + l * CM_L + NI8 + DFF + c0;
#pragma unroll
            for (int e = 0; e < 4; ++e) atomicMax(cm + e, __float_as_uint(m[e]));
        }
        if (!MK_MULTI) xcd_barrier(bar);
        conv_stream<true>(args, scr, lane, 0, IT_LW + (IT_ALL - IT_W), gw, ngw, IT_LW, IT_W - IT_LW);
        { float* c8t = (float*)(ws + WS_PA); const float* lam = args.in[I_LAM];
          for (int i = gw * 64 + lane; i < DEPTH * LW; i += ngw * 64) c8t[i] = 8.0f * log1pf(__expf(-lam[i])); }
        { bf16_t* wat = (bf16_t*)(ws + WS_WAT); bf16_t* wit = (bf16_t*)(ws + WS_WIT); const float* wa = args.in[I_LWA]; const float* wi = args.in[I_LWI];
          for (int i = gw * 64 + lane; i < DEPTH * LHEADS * 64 * 64; i += ngw * 64) { const int hh = i >> 12, jj = (i >> 6) & 63, ii = i & 63; wat[i] = f2bf(wa[(hh * 64 + ii) * 64 + jj]); wit[i] = f2bf(wi[(hh * 64 + ii) * 64 + jj]); } }
        { bf16_t* sl = (bf16_t*)(ws + WS_SLCB); const float* s = args.in[I_SLC]; const int n8 = DEPTH * DBATCH * 3 * LW / 8;
          for (int i = gw * 64 + lane; i < n8; i += ngw * 64) { const f32x4 a = *(const f32x4*)(s + (size_t)i * 8), b = *(const f32x4*)(s + (size_t)i * 8 + 4); *(u32x4*)(sl + (size_t)i * 8) = pack8(a, b); } }
        { bf16_t* XB = (bf16_t*)(ws + WS_XB);
          for (int row = gw; row < MT; row += ngw) { const float* xr = row < MP ? args.in[I_XP] + (size_t)row * DM : args.in[I_XS] + (size_t)(row - MP) * DM; const float sc = row_to_bf16_normed(xr, XB + (size_t)row * DM, lane, ws + WS_XQ + (size_t)row * DM, (float*)(ws + WS_SA) + row); if (lane == 0) ((float*)(ws + WS_SSX))[row] = sc; } }
        { bf16_t* MB = (bf16_t*)(ws + WS_MEMB);
          for (int row = gw; row < NBATCH * MEMLEN; row += ngw) row_to_bf16_normed(args.in[I_MEM] + (size_t)row * DM, MB + (size_t)row * DM, lane); }
        __syncthreads();
    }
    SEAM(0);

    for (int l = 0; l < DEPTH; ++l) {
        const int pb = 1 + 9 * l;
        if (IN(pb + 0)) {
#ifndef NO_KV
            if (l == 0) {
                pg8::Gemm g{(const char*)(ws + WS_MEMB), (const char*)(ws + WS_WKV), DM, DM, DM, 0, 0};
                pg8::KvOrder S{bx};
                pg8::EpiKV E{args.out + O_PMK, args.out + O_PMV, (bf16_t*)(ws + WS_KP), (bf16_t*)(ws + WS_VTP)};
                pg8::gemm_phase<pg8::EpiKV, pg8::KvOrder>(lds, g, S, E);
            }
#endif

#ifndef NO_GIN
            {
                pg8::Gemm g{(const char*)(ws + WS_XB), (const char*)(ws + WS_WIN + l * SZ_WIN), DM, DM, DM, 0, 0};
                pg8::StaticOrder S; S.init(MT, C_I8, G, bx); S.ntk = DM / 64;
                pg8::EpiIn E{(bf16_t*)(ws + WS_PROJ), args.in[I_BGATE] + (size_t)l * 3 * DM};
                for (int rr = 0; rr < DUP_GIN; ++rr) pg8::gemm_phase<pg8::EpiIn, pg8::StaticOrder>(lds, g, S, E);
            }
            {
                pg8::Gemm g{(const char*)(ws + WS_XQ), (const char*)(ws + WS_WIN + l * SZ_WIN + WQ_OFF), DM / 2, DM / 2, DM / 2, 0, 0};
                pg8::StaticOrder S; S.init(MT, NI8, G, G - 1 - bx); S.ntk = DM / 128;
                pg8::EpiIn8 E{(bf16_t*)(ws + WS_PROJ), args.in[I_BGATE] + (size_t)l * 3 * DM, (const float*)(ws + WS_SA), (const unsigned*)(ws + WS_CTL) + CW_CMAX + l * CM_L, ws + WS_G8};
                pg8::gemm_phase<pg8::EpiIn8, pg8::StaticOrder, true>(lds, g, S, E);
            }
#endif
        }
        SEAM(pb + 0);
        if (IN(pb + 2)) for (int rep = 0; rep < DUP_THIN; ++rep) {
            if (rep) __syncthreads();
#ifndef NO_LRUF
            for (int rr = 0; rr < DUP_LRU; ++rr)
            for (int u = vcu; u < 64 * LHEADS; u += G) lru_unit<true, false>(args, l, u >> 4, u & 15, lds, wave, lane);
            for (int u = 64 * LHEADS + vcu; u < NPANEL * LHEADS; u += G) lru_unit<true, true>(args, l, u >> 4, u & 15, lds, wave, lane);
#endif
#ifndef NO_ATTN
            for (int u = vcu; u < 256; u += G) attn_wg_unit(args, l, u, lds, tid);
            if (G == 256) {
                if (vcu >= 128) attn_sample_unit(args, l, vcu - 128, lds, tid);
#ifndef NO_SCONV
                if (vcu >= 64) for (int it = (vcu - 64) * 8 + wave; it < (MT / 8) * 2; it += 192 * 8) sconv_item(args, l, it, lane);
#endif
            } else {
                for (int u = vcu; u < 128; u += G) attn_sample_unit(args, l, u, lds, tid);
#ifndef NO_SCONV
                for (int it = gw; it < (MT / 8) * 2; it += ngw) sconv_item(args, l, it, lane);
#endif
            }
#endif
        }
        SEAM(pb + 2);
        if (IN(pb + 3)) {
#ifndef NO_GBR
            pg8::Gemm g{(const char*)(ws + WS_ABR), (const char*)(ws + WS_WBR + (size_t)l * 3 * SZ_WBR1), 1024, 1024, 1024, SZ_ABR1, SZ_WBR1};
            pg8::Seg3Order S; S.init(MP, DM, G, bx); S.ntk = 1024 / 64;
            pg8::EpiBranch E{(const unsigned char*)(ws + WS_G8), (bf16_t*)(ws + WS_MERGED)};
            for (int rr = 0; rr < DUP_GBR; ++rr) pg8::gemm_phase<pg8::EpiBranch, pg8::Seg3Order>(lds, g, S, E);
            pg8::SegSubOrder S2{bx}; pg8::EpiPart E2{(float*)(ws + WS_BP)};
            pg8::gemm_phase<pg8::EpiPart, pg8::SegSubOrder>(lds, g, S2, E2);
            if (l + 1 < DEPTH && G == 256 && bx >= 96)
                conv_stream<false>(args, (LAS float*)(lds + wave * 16384), lane, (l + 1) * IT_LW, (l + 1) * IT_LW + CV_B, (bx - 96) * 8 + wave, 160 * 8);
#endif

        }
        SEAM(pb + 3);
        if (IN(pb + 4)) {
            {
                const float* bp = (const float*)(ws + WS_BP); const bf16_t* PROJ = (const bf16_t*)(ws + WS_PROJ); bf16_t* Mg = (bf16_t*)(ws + WS_MERGED);
                int ln = lane; asm volatile("" : "+v"(ln));
                for (int i = gw * 64 + ln; i < MS * DM / 8; i += ngw * 64) {
                    const int r = i >> 8, c = (i & 255) * 8;
                    f32x4 o0 = (f32x4){0.f, 0.f, 0.f, 0.f}, o1 = o0;
#pragma unroll
                    for (int s = 0; s < 3; ++s) {
                        const float* pp = bp + ((size_t)s * MS + r) * DM + c; f32x4 g0, g1; pg8::unpack8u(*(const u32x2*)(ws + WS_G8 + pg8::g8_tile(64 + (r >> 8), s * 8 + (c >> 8)) + ((((r >> 6) & 1) * 4 + ((c >> 6) & 3)) * 16 + (((r >> 7) & 1) * 4 + ((r >> 4) & 3)) * 2 + ((c >> 5) & 1)) * 512 + (((c >> 3) & 3) * 16 + (r & 15)) * 8), g0, g1); g0 = g0 * (1.0f / 255.0f); g1 = g1 * (1.0f / 255.0f);
                        o0 += g0 * *(const f32x4*)pp; o1 += g1 * *(const f32x4*)(pp + 4);
                    }
                    *(u32x4*)(Mg + (size_t)(MP + r) * DM + c) = pack8(o0, o1);
                }
                if (!MK_MULTI) xcd_barrier(bar);
            }
#ifndef NO_GOUT
            pg8::Gemm g{(const char*)(ws + WS_MERGED), (const char*)(ws + WS_WOUT + l * SZ_WOUT), DM, DM, DM, 0, 0};
            pg8::SplitOrder S; S.init(MP, DM, G, bx); S.ntk = DM / 64;
            pg8::EpiY E{(bf16_t*)(ws + WS_Y), (float*)(ws + WS_SSY), (float*)(ws + WS_PROJ)};
            for (int rr = 0; rr < DUP_GOUT; ++rr) pg8::gemm_phase<pg8::EpiY, pg8::SplitOrder>(lds, g, S, E);
#endif

        }
        SEAM(pb + 4);
        if (IN(pb + 5)) norm_rows(args, args.in[I_GMIXPOST] + (size_t)l * DM, (const float*)(ws + WS_PROJ), true, false, true, gw, ngw, lane);
        SEAM(pb + 5);
        if (IN(pb + 6)) {
#ifndef NO_GUP
            pg8::Gemm g{(const char*)(ws + WS_XQ), (const char*)(ws + WS_WUP + l * SZ_WUP), DM / 2, DM / 2, DM / 2, 0, 0};
            pg8::UpOrder S{bx, G, DM / 128};
            for (int rr = 0; rr < DUP_GUP; ++rr) {
            pg8::EpiUp8 E{ws, l, l * DUP_GUP + rr + 1};
            pg8::gemm_phase<pg8::EpiUp8, pg8::UpOrder, true>(lds, g, S, E); }
            if (l + 1 < DEPTH && G == 256 && bx >= 128)
                conv_stream<false>(args, (LAS float*)(lds + wave * 16384), lane, (l + 1) * IT_LW + CV_B, (l + 2) * IT_LW, (bx - 128) * 8 + wave, 128 * 8);
#endif

        }
        SEAM(pb + 6);
        if (IN(pb + 7)) {
#ifndef NO_GDN
            pg8::Gemm g{(const char*)(ws + WS_PROJ), (const char*)(ws + WS_WDN + l * SZ_WUP), DFF / 2, DFF / 2, DFF / 2, 0, 0};
            pg8::SplitOrder S; S.init(MP, DM, G, bx); S.ntk = DFF / 128;
            pg8::EpiY8 E{(bf16_t*)(ws + WS_Y), (float*)(ws + WS_SSY), (float*)(ws + WS_MERGED), (const unsigned*)(ws + WS_CTL) + CW_RMAX + l * MT,
                         (const unsigned*)(ws + WS_CTL) + CW_CMAX + l * CM_L + NI8 + DFF, (const int*)(ws + WS_CTL) + cw_csum9(l)};
            for (int rr = 0; rr < DUP_GDN; ++rr) pg8::gemm_phase<pg8::EpiY8, pg8::SplitOrder, true>(lds, g, S, E);
#endif

        }
        SEAM(pb + 7);
        if (IN(pb + 8)) norm_rows(args, args.in[I_GMLPPOST] + (size_t)l * DM, (const float*)(ws + WS_MERGED), true, l == DEPTH - 1, true, gw, ngw, lane);
        SEAM(pb + 8);
    }
#undef IN
#undef SEAM
}

extern "C" void kernel_launch(void* const* d_in, const int* in_sizes, int n_in, void* d_out, int out_size, void* d_ws, size_t ws_size, hipStream_t stream) {
    static int grid = 0;
    if (grid == 0) {
        if (n_in != 30 || out_size != (int)O_END || ws_size < WS_END) { fprintf(stderr, "kernel_launch: unexpected shapes (n_in %d, out %d, ws %zu < %zu)\n", n_in, out_size, ws_size, (size_t)WS_END); grid = -1; return; }
        int dev = 0, cus = 0, per_cu = 0;
        if (hipGetDevice(&dev) != hipSuccess || hipDeviceGetAttribute(&cus, hipDeviceAttributeMultiprocessorCount, dev) != hipSuccess) { grid = -1; return; }
        if (hipFuncSetAttribute((const void*)mk_fwd, hipFuncAttributeMaxDynamicSharedMemorySize, LDS_BYTES) != hipSuccess) { fprintf(stderr, "kernel_launch: hipFuncSetAttribute failed\n"); grid = -1; return; }
        if (hipOccupancyMaxActiveBlocksPerMultiprocessor(&per_cu, (const void*)mk_fwd, 512, LDS_BYTES) != hipSuccess || per_cu < 1) fprintf(stderr, "kernel_launch: occupancy query reports %d\n", per_cu);
        (void)hipGetLastError();
        grid = cus;
    }
    if (grid < 0) return;
    static_assert(WS_GRAN == 0 && WS_CTL == 1 * MiB, "the two zeroed regions are adjacent");
    if (hipMemsetAsync((char*)d_ws + WS_GRAN, 0, 1 * MiB + CTL_ZERO_BYTES, stream) != hipSuccess) return;
    Args a{};
    for (int i = 0; i < 30; ++i) a.in[i] = (const float*)d_in[i];
    a.out = (float*)d_out; a.ws = (unsigned char*)d_ws;
#if MK_MULTI
    for (int p = 0; p < NPH; ++p) { a.ph_lo = p; a.ph_hi = p + 1; hipLaunchKernelGGL(mk_fwd, dim3(grid), dim3(512), LDS_BYTES, stream, a); }
#else
    a.ph_lo = 0; a.ph_hi = NPH;
    hipLaunchKernelGGL(mk_fwd, dim3(grid), dim3(512), LDS_BYTES, stream, a);
#endif
}
```

```cpp
#include <hip/hip_runtime.h>
#include <cstdio>
#include <cstdint>

#define LAS __attribute__((address_space(3)))
#define GAS __attribute__((address_space(1)))
typedef unsigned short bf16_t;
typedef short bf16x8 __attribute__((ext_vector_type(8)));
typedef short s16x4 __attribute__((ext_vector_type(4)));
typedef float f32x4 __attribute__((ext_vector_type(4)));
typedef float f32x2 __attribute__((ext_vector_type(2)));
typedef float f32x16 __attribute__((ext_vector_type(16)));
typedef unsigned u32x4 __attribute__((ext_vector_type(4)));
typedef unsigned u32x2 __attribute__((ext_vector_type(2)));
typedef __bf16 bf16x2_t __attribute__((ext_vector_type(2)));

#ifndef DUP_THIN
#define DUP_THIN 1
#endif
#ifndef DUP_LRU
#define DUP_LRU 1
#endif
#ifndef DUP_ATT
#define DUP_ATT 1
#endif
#ifndef DUP_SC
#define DUP_SC 1
#endif
#ifndef DUP_NORM
#define DUP_NORM 1
#endif
#ifndef DUP_BAR
#define DUP_BAR 1
#endif
#ifndef DUP_PRO
#define DUP_PRO 1
#endif
#ifndef DUP_GIN
#define DUP_GIN 1
#endif
#ifndef DUP_GDN
#define DUP_GDN 1
#endif
#ifndef DUP_GUP
#define DUP_GUP 1
#endif
#ifndef DUP_GBR
#define DUP_GBR 1
#endif
#ifndef DUP_GOUT
#define DUP_GOUT 1
#endif
#ifndef PG8_SP2
#define PG8_SP2 1
#endif
#ifndef PG8_ALIGN
#define PG8_ALIGN 1
#endif
#ifndef MK_MULTI
#define MK_MULTI 0
#endif

constexpr int DM = 2048, NBATCH = 2, SEQ = 8192, DEPTH = 4, DBATCH = 32, DSEQ = 32;
constexpr int MP = NBATCH * SEQ, MS = DBATCH * DSEQ, MT = MP + MS;
constexpr int LW = 1024, LHEADS = 16, LHD = 64;
constexpr int MEMLEN = 256, MHEADS = 4, MHD = 256, MW = 1024;
constexpr int INC = 12288, DFF = 8192;
constexpr int NPANEL = MT / 256;
constexpr float EPS = 1e-6f;
constexpr float LOG2E = 1.4426950408889634f;
constexpr int C_LX = 0, C_LG = 1024, C_SB = 2048, C_SC = 3072, C_SH = 4096, C_Q = 5120, C_GT = 6144;
constexpr int C_I8 = 5120, NI8 = 12288 - C_I8;

constexpr size_t O_YP = 0, O_YS = (size_t)MP * DM, O_PLH = O_YS + (size_t)MS * DM, O_PLC = O_PLH + DEPTH * NBATCH * LW,
                 O_PSC = O_PLC + DEPTH * NBATCH * 3 * LW, O_PMK = O_PSC + DEPTH * NBATCH * 2 * LW, O_PMV = O_PMK + (size_t)DEPTH * NBATCH * MEMLEN * MW,
                 O_SLH = O_PMV + (size_t)DEPTH * NBATCH * MEMLEN * MW, O_SLC = O_SLH + DEPTH * DBATCH * LW, O_SSC = O_SLC + DEPTH * DBATCH * 3 * LW,
                 O_END = O_SSC + DEPTH * DBATCH * 2 * LW;
static_assert(O_END == 40681472, "output size");

constexpr size_t MiB = 1u << 20;
constexpr size_t WS_CTL = 1 * MiB, CTL_ZERO_BYTES = 1 * MiB;
constexpr size_t WS_SSX = 2 * MiB;
constexpr size_t WS_SSY = WS_SSX + 128 * 1024;
constexpr size_t WS_MRSTD = WS_SSY + (size_t)MT * 32 * 4;
constexpr size_t WS_PA = 5 * MiB, WS_PB = WS_PA + 256 * 1024;
constexpr size_t WS_SLCB = WS_PB + 256 * 1024;
constexpr size_t WS_WAT = WS_SLCB + 768 * 1024, WS_WIT = WS_WAT + 512 * 1024;
constexpr size_t WS_MEMB = WS_WIT + 512 * 1024;
static_assert(WS_MEMB + 2 * MiB <= 10 * MiB, "small buffers below the weights");
constexpr size_t WS_GRAN = 0;
constexpr size_t WS_WIN = 10 * MiB;
constexpr size_t SZ_WIN = (size_t)INC * DM * 2;
constexpr size_t WS_WBR = WS_WIN + 4 * SZ_WIN;
constexpr size_t SZ_WBR1 = (size_t)DM * 1024 * 2;
constexpr size_t WS_WOUT = WS_WBR + 12 * SZ_WBR1;
constexpr size_t SZ_WOUT = (size_t)DM * DM * 2;
constexpr size_t WS_WUP = WS_WOUT + 4 * SZ_WOUT;
constexpr size_t SZ_WUP = (size_t)DFF * DM * 2;
constexpr size_t WS_WDN = WS_WUP + 4 * SZ_WUP;
constexpr size_t WS_WKV = WS_WDN + 4 * SZ_WUP;
constexpr size_t WS_XB = WS_WKV + 4 * SZ_WOUT;
constexpr size_t SZ_ACT2K = (size_t)MT * DM * 2;
constexpr size_t WS_PROJ = WS_XB + SZ_ACT2K;
constexpr size_t WS_ABR = WS_PROJ + (size_t)MT * INC * 2;
constexpr size_t SZ_ABR1 = (size_t)MT * 1024 * 2;
constexpr size_t WS_MERGED = WS_ABR + 3 * SZ_ABR1;
constexpr size_t WS_Y = WS_MERGED + SZ_ACT2K;
constexpr size_t WS_KP = WS_Y + SZ_ACT2K;
constexpr size_t WS_VTP = WS_KP + 4 * MiB;
constexpr size_t WS_KS = WS_VTP + 4 * MiB;
constexpr size_t WS_VTS = WS_KS + 64 * MiB;
constexpr size_t WS_G8 = WS_KS;
static_assert((size_t)MT * 3 * DM <= 128 * MiB, "gate bytes fit the old cache-copy area");
constexpr size_t WS_BP = WS_VTS + 64 * MiB;
constexpr size_t WS_XQ = WS_BP + 24 * MiB;
constexpr size_t WS_END = WS_XQ + (size_t)MT * DM;
constexpr size_t WS_SA = WS_MRSTD + 4096;
constexpr size_t WQ_OFF = (size_t)C_I8 * DM * 2;
constexpr int CW_CMAX = 16384, CM_L = NI8 + DFF + DM;
constexpr int CW_RCNT = 8192, CW_CSUM = 98304, CW_RMAX = 131072;
static_assert(CW_CMAX + DEPTH * CM_L <= CW_CSUM && CW_CSUM + DEPTH * DM <= CW_RMAX && (CW_RMAX + DEPTH * MT) * 4 <= (int)CTL_ZERO_BYTES, "control words inside the memset region");
__host__ __device__ constexpr int cw_csum9(int l) { return l < 3 ? CW_RMAX + DEPTH * MT + l * 9 * DM : CW_CSUM + DEPTH * DM; }
static_assert((CW_RMAX + DEPTH * MT + 3 * 9 * DM) * 4 <= (int)CTL_ZERO_BYTES && CW_CSUM + DEPTH * DM + 9 * DM <= CW_RMAX, "slice sums inside the memset region");
static_assert((CW_CMAX + DEPTH * CM_L) * 4 <= (int)CTL_ZERO_BYTES, "column maxima inside the memset region");
static_assert(WS_SA + (size_t)MT * 4 <= WS_PA && WS_END <= (size_t)1536 * MiB, "d_ws map");

constexpr int RING_BYTES = 131072;
constexpr int MISC_OFF = RING_BYTES;
constexpr int LDS_BYTES = 147456;

__device__ __forceinline__ unsigned cvtpk(float lo, float hi) { f32x2 v = {lo, hi}; bf16x2_t b = __builtin_convertvector(v, bf16x2_t); return __builtin_bit_cast(unsigned, b); }
__device__ __forceinline__ u32x4 pack8(f32x4 a, f32x4 b) { u32x4 w; w.x = cvtpk(a[0], a[1]); w.y = cvtpk(a[2], a[3]); w.z = cvtpk(b[0], b[1]); w.w = cvtpk(b[2], b[3]); return w; }
__device__ __forceinline__ float bf_lo(unsigned w) { return __uint_as_float(w << 16); }
__device__ __forceinline__ float bf_hi(unsigned w) { return __uint_as_float(w & 0xffff0000u); }
__device__ __forceinline__ float bf1(bf16_t v) { return __uint_as_float(((unsigned)v) << 16); }
__device__ __forceinline__ void unpack8(u32x4 w, f32x4& a, f32x4& b) { a = (f32x4){bf_lo(w.x), bf_hi(w.x), bf_lo(w.y), bf_hi(w.y)}; b = (f32x4){bf_lo(w.z), bf_hi(w.z), bf_lo(w.w), bf_hi(w.w)}; }
__device__ __forceinline__ bf16_t f2bf(float f) { return (bf16_t)(cvtpk(f, 0.f) & 0xffffu); }
__device__ __forceinline__ float fsigmoid(float v) { return __builtin_amdgcn_rcpf(1.0f + __builtin_amdgcn_exp2f(-LOG2E * v)); }
__device__ __forceinline__ float fgelu_tanh(float v) { const float t = v + 0.044715f * v * v * v; return v * __builtin_amdgcn_rcpf(1.0f + __builtin_amdgcn_exp2f(-2.3022081985f * t)); }
__device__ __forceinline__ float wave_sum(float v) {
#pragma unroll
    for (int o = 1; o < 64; o <<= 1) v += __shfl_xor(v, o);
    return v;
}
#define LDS_WAIT() asm volatile("s_waitcnt lgkmcnt(0)" ::: "memory")
#define VM_WAIT() asm volatile("s_waitcnt vmcnt(0)" ::: "memory")

namespace pg8 {
constexpr int BM = 256, BK = 64, HALF = 128, HTB = HALF * BK * 2, STAGE_BYTES = 8 * HTB, NXCD = 8, WGM = 8;
__host__ __device__ __forceinline__ int lds_byte(int r, int c) { const int st = (r >> 4) * 2 + (c >> 5), rr = r & 15, cc = c & 31, ob = rr * 64 + cc * 2; return st * 1024 + (ob ^ (((ob >> 9) & 1) << 5)); }
__host__ __device__ __forceinline__ void stage_rc(int b, int& R, int& C) { const int st = b / 1024, sb = b % 1024, swz = sb ^ (((sb >> 9) & 1) << 5); R = (st >> 1) * 16 + swz / 64; C = (st & 1) * 32 + (swz % 64) / 2; }
__host__ __device__ __forceinline__ int perm32(int rho) { const int n = rho >> 4, i = rho & 15; return 8 * (i >> 2) + 4 * n + (i & 3); }

struct Unit { int pm, pn, seg, ks, nt, koff; };
struct Gemm { const char* A; const char* Bt; int lda, ldb, K; size_t segA, segB; };

struct StaticOrder {
    int nM, nN, nwg, G, c, wgm;
    __device__ __forceinline__ void init(int M, int N, int G_, int c_) { nM = M / BM; nN = N / BM; nwg = nM * nN; G = G_; c = c_; wgm = nN <= 8 ? 4 : WGM; }
    __device__ __forceinline__ bool unit(int i, Unit& u) const {
        const long L = (long)i * G + c; const bool ok = L < nwg;
        int wgid = ok ? (int)L : 0; { const int q = nwg / NXCD, r = nwg % NXCD, xcd = wgid % NXCD, off = wgid / NXCD; wgid = (xcd < r ? xcd * (q + 1) : r * (q + 1) + (xcd - r) * q) + off; }
        const int nig = wgm * nN, gid = wgid / nig, fm = gid * wgm, gsz = (nM - fm) < wgm ? (nM - fm) : wgm;
        u.pm = fm + ((wgid % nig) % gsz); u.pn = (wgid % nig) / gsz; return ok;
    }
    int ntk;
    __device__ __forceinline__ bool next(int i, Unit& u) const { u.seg = 0; u.ks = -1; u.nt = ntk; u.koff = 0; return unit(i, u); }
};
struct SplitOrder : StaticOrder {
    __device__ __forceinline__ bool next(int i, Unit& u) const {
        Unit a; const bool oka = unit(i < 2 ? i : 0, a);
        const bool sp = i >= 2; const int tile = c >> 3;
        u.seg = 0; u.pm = sp ? 64 + (tile >> 3) : a.pm; u.pn = sp ? (tile & 7) : a.pn; u.ks = sp ? (c & 7) : -1; u.nt = sp ? (ntk >> 3) : ntk; u.koff = sp ? (c & 7) * (ntk >> 3) * (BK * 2) : 0;
        return sp ? (i == 2 && c < 256) : oka;
    }
};
struct Seg3Order : StaticOrder {
    __device__ __forceinline__ bool next(int i, Unit& u) const { const int t = i / 3; u.seg = i - 3 * t; u.ks = -1; u.nt = ntk; u.koff = 0; return unit(t, u); }
};
struct SegSubOrder {
    int c;
    __device__ __forceinline__ bool next(int i, Unit& u) const {
        const int tile = c / 3, sg = c - 3 * tile;
        u.pm = 64 + (tile >> 3); u.pn = tile & 7; u.seg = sg; u.ks = sg; u.nt = 1024 / BK; u.koff = 0;
        return i == 0 && c < 96;
    }
};
struct UpOrder {
    int c, G, ntk;
    __device__ __forceinline__ bool next(int i, Unit& u) const {
        const int x = c & 7, j = c >> 3; const bool last = i >= 8, lin = G != 256; const int L = i * G + c;
        const int pm = last ? 64 + (x >> 1) : 8 * i + 4 * (x >> 2) + (j & 3), pn = last ? 16 * (x & 1) + (j & 15) : 8 * (x & 3) + (j >> 2);
        u.pm = lin ? (L >> 5) : pm; u.pn = lin ? (L & 31) : pn; u.seg = 0; u.ks = -1; u.nt = ntk; u.koff = 0;
        return lin ? (L < (MT / BM) * (DFF / BM)) : (last ? (i == 8 && j < 16) : true);
    }
};
struct KvOrder {
    int c;
    __device__ __forceinline__ bool next(int i, Unit& u) const { if (i > 0 || c < 80 || c >= 144) return false; const int k = c - 80; u.pm = k & 1; u.pn = k >> 1; u.seg = 0; u.ks = -1; u.nt = DM / BK; u.koff = 0; return true; }
};

typedef int v4i_t __attribute__((ext_vector_type(4)));
template <bool I8> __device__ __forceinline__ f32x4 mma16(bf16x8 b, bf16x8 a, f32x4 c) {
    if constexpr (I8) return __builtin_bit_cast(f32x4, __builtin_amdgcn_mfma_i32_16x16x64_i8(__builtin_bit_cast(v4i_t, b), __builtin_bit_cast(v4i_t, a), __builtin_bit_cast(v4i_t, c), 0, 0, 0));
    else return __builtin_amdgcn_mfma_f32_16x16x32_bf16(b, a, c, 0, 0, 0);
}
template <class T, class = void> struct epi_wide { static constexpr bool value = false; };
template <class T> struct epi_wide<T, decltype((void)T::WIDE)> { static constexpr bool value = true; };
template <class Epi, class Sched, bool I8 = false>
__device__ __forceinline__ void gemm_phase(LAS unsigned char* lds, const Gemm g, const Sched& S, const Epi& E) {
    int tid = threadIdx.x; asm volatile("" : "+v"(tid));
    const int wid = __builtin_amdgcn_readfirstlane(tid >> 6), lane = tid & 63, wr = wid >> 2, wc = wid & 3, fr = lane & 15, fq = lane >> 4;
    unsigned voffA[2], voffB[2];
#pragma unroll
    for (int i = 0; i < 2; ++i) { int R, C; stage_rc(tid * 16 + i * 8192, R, C); const int Rb = Epi::PERM ? ((R >> 5) * 64 + perm32(R & 31)) : R;
        voffA[i] = (unsigned)(R * g.lda + C) * 2u; voffB[i] = (unsigned)(Rb * g.ldb + C) * 2u; }
    const size_t kstep = (size_t)(BK * 2);
    const size_t hstepA = (size_t)HALF * g.lda * 2, hstepB = (size_t)(Epi::PERM ? 32 : HALF) * g.ldb * 2;
    const size_t tstepA = 2 * hstepA, tstepB = (size_t)BM * g.ldb * 2;
    const unsigned ldsw = (unsigned)wid * 1024u;
    const int aoff = lds_byte(wr * 64 + fr, fq * 8), boff = lds_byte(wc * 32 + fr, fq * 8);
#define PG8_SA(b, h) (((b) * 2 + (h)) * HTB)
#define PG8_SB(b, h) ((4 + (b) * 2 + (h)) * HTB)
#define PG8_STAGE(bufoff, gbase, voff) do { _Pragma("unroll") for (int _i = 0; _i < 2; ++_i) \
        __builtin_amdgcn_global_load_lds((const unsigned*)((const char*)(gbase) + (voff)[_i]), (LAS unsigned*)(lds + (bufoff) + ldsw + _i * 8192), 16, 0, 0); } while (0)
#define PG8_LDA(dst, b, h) do { _Pragma("unroll") for (int m = 0; m < 4; ++m) _Pragma("unroll") for (int k = 0; k < 2; ++k) dst[m][k] = *(const LAS bf16x8*)(lds + PG8_SA(b, h) + aoff + m * 2048 + k * 1024); } while (0)
#define PG8_LDB(dst, b, h) do { _Pragma("unroll") for (int n = 0; n < 2; ++n) _Pragma("unroll") for (int k = 0; k < 2; ++k) dst[n][k] = *(const LAS bf16x8*)(lds + PG8_SB(b, h) + boff + n * 2048 + k * 1024); } while (0)
#define PG8_MMA(ai, bj, At, Bt) do { __builtin_amdgcn_s_setprio(1); _Pragma("unroll") for (int m = 0; m < 4; ++m) _Pragma("unroll") for (int n = 0; n < 2; ++n) _Pragma("unroll") for (int k = 0; k < 2; ++k) \
        acc[ai][bj][m][n] = mma16<I8>(Bt[n][k], At[m][k], acc[ai][bj][m][n]); __builtin_amdgcn_s_setprio(0); } while (0)
#define PG8_WAIT_V(n) asm volatile("s_waitcnt vmcnt(" #n ")" ::: "memory")
#define PG8_WAIT_L(n) asm volatile("s_waitcnt lgkmcnt(" #n ")" ::: "memory")
#define PG8_BAR __builtin_amdgcn_s_barrier()
#define PG8_SCHED __builtin_amdgcn_sched_barrier(0)
    Unit cur, nxt; int ui = 0;
    if (!S.next(0, cur)) return;
    f32x4 acc[2][2][4][2];
#pragma unroll
    for (int a = 0; a < 2; ++a)
#pragma unroll
        for (int b = 0; b < 2; ++b)
#pragma unroll
            for (int m = 0; m < 4; ++m)
#pragma unroll
                for (int n = 0; n < 2; ++n) acc[a][b][m][n] = (f32x4){0.f, 0.f, 0.f, 0.f};
    bf16x8 At[4][2], B0[2][2], B1[2][2];
    const char* cA = g.A + (size_t)cur.seg * g.segA + (size_t)cur.pm * tstepA + cur.koff; const char* cB = g.Bt + (size_t)cur.seg * g.segB + (size_t)cur.pn * tstepB + cur.koff;
    if (PG8_SP2) {
    PG8_STAGE(PG8_SB(0, 0), cB, voffB); PG8_STAGE(PG8_SB(0, 1), cB + hstepB, voffB); PG8_STAGE(PG8_SA(0, 0), cA, voffA); PG8_STAGE(PG8_SA(0, 1), cA + hstepA, voffA);
    if (wr == 1) PG8_BAR;
    PG8_WAIT_V(2); PG8_BAR;
    PG8_STAGE(PG8_SB(1, 0), cB + kstep, voffB); PG8_STAGE(PG8_SA(1, 0), cA + kstep, voffA); PG8_STAGE(PG8_SB(1, 1), cB + hstepB + kstep, voffB);
    PG8_WAIT_V(6); PG8_BAR;
    } else {
    PG8_STAGE(PG8_SB(0, 0), cB, voffB); PG8_STAGE(PG8_SA(0, 0), cA, voffA); PG8_STAGE(PG8_SB(0, 1), cB + hstepB, voffB); PG8_STAGE(PG8_SA(0, 1), cA + hstepA, voffA);
    if (wr == 1) PG8_BAR;
    PG8_WAIT_V(4); PG8_BAR;
    PG8_STAGE(PG8_SB(1, 0), cB + kstep, voffB); PG8_STAGE(PG8_SA(1, 0), cA + kstep, voffA); PG8_STAGE(PG8_SB(1, 1), cB + hstepB + kstep, voffB);
    PG8_WAIT_V(6); PG8_BAR;
    }
    for (;;) {
        const bool has_next = S.next(ui + 1, nxt);
        const char* nA = has_next ? g.A + (size_t)nxt.seg * g.segA + (size_t)nxt.pm * tstepA + nxt.koff : cA; const char* nB = has_next ? g.Bt + (size_t)nxt.seg * g.segB + (size_t)nxt.pn * tstepB + nxt.koff : cB;
        const int nt = cur.nt;
        for (int t = 0; t < nt; t += 2) {
            const bool last = (t == nt - 2);
            const char* a1 = cA + (size_t)(t + 1) * kstep;
            const char* a2 = last ? nA : cA + (size_t)(t + 2) * kstep; const char* b2 = last ? nB : cB + (size_t)(t + 2) * kstep;
            const char* a3 = a2 + kstep; const char* b3 = b2 + kstep;
            if (PG8_SP2) {
            PG8_LDB(B0, 0, 0); PG8_LDB(B1, 0, 1); PG8_SCHED; PG8_LDA(At, 0, 0); PG8_STAGE(PG8_SA(1, 1), a1 + hstepA, voffA);
            PG8_WAIT_V(8); PG8_WAIT_L(0); PG8_BAR; PG8_MMA(0, 0, At, B0); PG8_MMA(0, 1, At, B1); PG8_BAR; PG8_SCHED;
            PG8_LDA(At, 0, 1); PG8_STAGE(PG8_SB(0, 0), b2, voffB); PG8_STAGE(PG8_SB(0, 1), b2 + hstepB, voffB); PG8_STAGE(PG8_SA(0, 0), a2, voffA);
            PG8_WAIT_V(8); PG8_WAIT_L(0); PG8_BAR; PG8_MMA(1, 0, At, B0); PG8_MMA(1, 1, At, B1); PG8_BAR; PG8_SCHED;
            PG8_LDB(B0, 1, 0); PG8_LDB(B1, 1, 1); PG8_SCHED; PG8_LDA(At, 1, 0); PG8_STAGE(PG8_SA(0, 1), a2 + hstepA, voffA);
            PG8_WAIT_V(8); PG8_WAIT_L(0); PG8_BAR; PG8_MMA(0, 0, At, B0); PG8_MMA(0, 1, At, B1); PG8_BAR; PG8_SCHED;
            PG8_LDA(At, 1, 1); PG8_STAGE(PG8_SB(1, 0), b3, voffB); PG8_STAGE(PG8_SB(1, 1), b3 + hstepB, voffB); PG8_STAGE(PG8_SA(1, 0), a3, voffA);
            PG8_WAIT_V(8); PG8_WAIT_L(0); PG8_BAR; PG8_MMA(1, 0, At, B0); PG8_MMA(1, 1, At, B1); PG8_BAR; PG8_SCHED;
            } else {
            PG8_LDB(B0, 0, 0); PG8_SCHED; PG8_LDA(At, 0, 0); PG8_STAGE(PG8_SA(1, 1), a1 + hstepA, voffA);
            PG8_WAIT_L(8); PG8_BAR; PG8_WAIT_L(0); PG8_MMA(0, 0, At, B0); PG8_BAR; PG8_SCHED;
            PG8_LDB(B1, 0, 1); PG8_STAGE(PG8_SB(0, 0), b2, voffB);
            PG8_BAR; PG8_WAIT_L(0); PG8_MMA(0, 1, At, B1); PG8_BAR;
            PG8_LDA(At, 0, 1); PG8_STAGE(PG8_SA(0, 0), a2, voffA);
            PG8_BAR; PG8_WAIT_L(0); PG8_MMA(1, 0, At, B0); PG8_BAR; PG8_SCHED;
            PG8_STAGE(PG8_SB(0, 1), b2 + hstepB, voffB);
            PG8_WAIT_V(6); PG8_BAR; PG8_MMA(1, 1, At, B1); PG8_BAR;
            PG8_LDB(B0, 1, 0); PG8_SCHED; PG8_LDA(At, 1, 0); PG8_STAGE(PG8_SA(0, 1), a2 + hstepA, voffA);
            PG8_WAIT_L(8); PG8_BAR; PG8_WAIT_L(0); PG8_MMA(0, 0, At, B0); PG8_BAR; PG8_SCHED;
            PG8_LDB(B1, 1, 1); PG8_STAGE(PG8_SB(1, 0), b3, voffB);
            PG8_BAR; PG8_WAIT_L(0); PG8_MMA(0, 1, At, B1); PG8_BAR;
            PG8_LDA(At, 1, 1); PG8_STAGE(PG8_SA(1, 0), a3, voffA);
            PG8_BAR; PG8_WAIT_L(0); PG8_MMA(1, 0, At, B0); PG8_BAR; PG8_SCHED;
            PG8_STAGE(PG8_SB(1, 1), b3 + hstepB, voffB);
            PG8_WAIT_V(6); PG8_BAR; PG8_MMA(1, 1, At, B1); PG8_BAR;
            }
        }
        if (PG8_ALIGN) { if (wr == 0) PG8_BAR; }
        { Unit eu = cur; eu.pm = __builtin_amdgcn_readfirstlane(eu.pm); eu.pn = __builtin_amdgcn_readfirstlane(eu.pn); eu.seg = __builtin_amdgcn_readfirstlane(eu.seg); eu.ks = __builtin_amdgcn_readfirstlane(eu.ks); asm volatile("" : "+s"(eu.pm), "+s"(eu.pn), "+s"(eu.seg), "+s"(eu.ks));
          if constexpr (epi_wide<Epi>::value) E(acc, eu, wr, wc, fr, fq, wid, lds); else E(acc, eu, wr, wc, fr, fq); }
        if (!has_next) break;
        if (nxt.seg == 0 || nxt.ks >= 0) {
#pragma unroll
            for (int a = 0; a < 2; ++a)
#pragma unroll
                for (int b = 0; b < 2; ++b)
#pragma unroll
                    for (int m = 0; m < 4; ++m)
#pragma unroll
                        for (int n = 0; n < 2; ++n) acc[a][b][m][n] = (f32x4){0.f, 0.f, 0.f, 0.f};
        }
        cur = nxt; cA = nA; cB = nB; ++ui;
        if (PG8_ALIGN) { if (wr == 1) PG8_BAR; }
    }
    PG8_WAIT_V(0);
    if (!PG8_ALIGN) { if (wr == 0) PG8_BAR; }
    PG8_BAR;
#undef PG8_SA
#undef PG8_SB
#undef PG8_STAGE
#undef PG8_LDA
#undef PG8_LDB
#undef PG8_MMA
#undef PG8_WAIT_V
#undef PG8_WAIT_L
#undef PG8_BAR
#undef PG8_SCHED
}

constexpr int CBJ = 32;
__device__ __forceinline__ unsigned dpp_ror8(unsigned v) { return (unsigned)__builtin_amdgcn_update_dpp(0, (int)v, 0x128, 0xF, 0xF, false); }
__device__ __forceinline__ void store_pair(bf16_t* grp  , size_t ld, int fr, int fq, u32x4 P0, u32x4 P1) {
    const bool up = (fr & 8) != 0;
    u32x4 snd, rcv;
    snd.x = up ? P0.x : P1.x; snd.y = up ? P0.y : P1.y; snd.z = up ? P0.z : P1.z; snd.w = up ? P0.w : P1.w;
    rcv.x = dpp_ror8(snd.x); rcv.y = dpp_ror8(snd.y); rcv.z = dpp_ror8(snd.z); rcv.w = dpp_ror8(snd.w);
    u32x4 dA, dB;
    dA.x = up ? rcv.x : P0.x; dA.y = up ? rcv.y : P0.y; dA.z = up ? rcv.z : P0.z; dA.w = up ? rcv.w : P0.w;
    dB.x = up ? P1.x : rcv.x; dB.y = up ? P1.y : rcv.y; dB.z = up ? P1.z : rcv.z; dB.w = up ? P1.w : rcv.w;
    bf16_t* p = grp + (size_t)(fr & 7) * ld + (up ? CBJ : 0) + 8 * fq;
    __builtin_nontemporal_store(dA, (u32x4*)p); __builtin_nontemporal_store(dB, (u32x4*)(p + 8 * ld));
}
__device__ __forceinline__ void store_pair8(unsigned char* grp  , size_t ld, int fr, int fq, u32x2 P0, u32x2 P1) {
    const bool up = (fr & 8) != 0;
    u32x2 snd, rcv, dA, dB;
    snd.x = up ? P0.x : P1.x; snd.y = up ? P0.y : P1.y;
    rcv.x = dpp_ror8(snd.x); rcv.y = dpp_ror8(snd.y);
    dA.x = up ? rcv.x : P0.x; dA.y = up ? rcv.y : P0.y;
    dB.x = up ? P1.x : rcv.x; dB.y = up ? P1.y : rcv.y;
    unsigned char* p = grp + (size_t)(fr & 7) * ld + (up ? CBJ : 0) + 8 * fq;
    __builtin_nontemporal_store(dA, (u32x2*)p); __builtin_nontemporal_store(dB, (u32x2*)(p + 8 * ld));
}
__device__ __forceinline__ unsigned gate_byte(float g) { return (unsigned)(int)__builtin_amdgcn_fmed3f(__builtin_rintf(g * 255.0f), 1.0f, 255.0f); }
__device__ __forceinline__ void unpack8u(u32x2 w, f32x4& a, f32x4& b) {
    a = (f32x4){(float)(w.x & 255u), (float)((w.x >> 8) & 255u), (float)((w.x >> 16) & 255u), (float)(w.x >> 24)};
    b = (f32x4){(float)(w.y & 255u), (float)((w.y >> 8) & 255u), (float)((w.y >> 16) & 255u), (float)(w.y >> 24)};
}
__device__ __forceinline__ size_t g8_tile(int pm, int gt) { return ((size_t)pm * 24 + gt) * 65536; }
struct EpiIn {
    static constexpr bool PERM = true;
    bf16_t* P; const float* bgate;
    __device__ __forceinline__ void operator()(f32x4 (&acc)[2][2][4][2], const Unit& u, int wr, int wc, int fr, int fq) const {
        const int rowg = u.pm * BM + wr * 64, colw = u.pn * BM + wc * 64, col0 = colw + 8 * fq, grp = u.pn >> 2;
        const int mode = grp == 1 ? 1 : (grp == 5 ? 2 : (grp >= 6 ? 3 : 0));
#pragma unroll
        for (int ai = 0; ai < 2; ++ai)
#pragma unroll
            for (int m = 0; m < 4; ++m) {
                u32x4 pk[2];
#pragma unroll
                for (int bj = 0; bj < 2; ++bj) {
                    f32x4 v0 = acc[ai][bj][m][0], v1 = acc[ai][bj][m][1];
                    if (mode == 1) {
#pragma unroll
                        for (int j = 0; j < 4; ++j) { v0[j] = fgelu_tanh(v0[j]); v1[j] = fgelu_tanh(v1[j]); }
                    } else if (mode == 2) { v0 = v0 * (0.0625f * LOG2E); v1 = v1 * (0.0625f * LOG2E); }
                    else if (mode == 3) {
                        v0 = v0 + *(const f32x4*)(bgate + (col0 - C_GT) + bj * CBJ); v1 = v1 + *(const f32x4*)(bgate + (col0 - C_GT) + bj * CBJ + 4);
#pragma unroll
                        for (int j = 0; j < 4; ++j) { v0[j] = fsigmoid(v0[j]); v1[j] = fsigmoid(v1[j]); }
                    }
                    pk[bj] = pack8(v0, v1);
                }
                store_pair(P + (size_t)(rowg + ai * HALF + m * 16) * INC + colw, INC, fr, fq, pk[0], pk[1]);
            }
    }
};
struct EpiIn8 {
    static constexpr bool PERM = true;
    bf16_t* P; const float* bgate; const float* sa; const unsigned* cmax; unsigned char* G8;
    __device__ __forceinline__ void operator()(f32x4 (&acc)[2][2][4][2], const Unit& u, int wr, int wc, int fr, int fq) const {
        const int rowg = u.pm * BM + wr * 64, colw = u.pn * BM + wc * 64, col0 = colw + 8 * fq;
        const int grp = (u.pn + C_I8 / BM) >> 2, mode = grp >= 6 ? 3 : (grp == 5 ? 2 : 0);
        if (mode == 3) {
            f32x4 cn[4], bn[4];
#pragma unroll
            for (int k = 0; k < 4; ++k) { const u32x4 c_ = *(const u32x4*)(cmax + col0 + (k >> 1) * CBJ + (k & 1) * 4); const f32x4 b_ = *(const f32x4*)(bgate + (col0 + C_I8 - C_GT) + (k >> 1) * CBJ + (k & 1) * 4);
#pragma unroll
                for (int j = 0; j < 4; ++j) { cn[k][j] = __uint_as_float(c_[j]) * -LOG2E; bn[k][j] = b_[j] * -LOG2E; } }
            float sv[8];
#pragma unroll
            for (int k = 0; k < 8; ++k) sv[k] = sa[rowg + (k >> 2) * HALF + (k & 3) * 16 + fr] * (1.0f / 127.0f);
#pragma unroll
            for (int ai = 0; ai < 2; ++ai)
#pragma unroll
                for (int m = 0; m < 4; ++m) {
                    const float s = sv[ai * 4 + m];
                    u32x2 gb[2];
#pragma unroll
                    for (int bj = 0; bj < 2; ++bj) {
                        const v4i_t i0 = __builtin_bit_cast(v4i_t, acc[ai][bj][m][0]), i1 = __builtin_bit_cast(v4i_t, acc[ai][bj][m][1]);
                        unsigned w0 = 0u, w1 = 0u;
#pragma unroll
                        for (int j = 0; j < 4; ++j) {
                            const float e0 = __builtin_amdgcn_exp2f(__builtin_fmaf((float)i0[j], s * cn[bj * 2][j], bn[bj * 2][j])), e1 = __builtin_amdgcn_exp2f(__builtin_fmaf((float)i1[j], s * cn[bj * 2 + 1][j], bn[bj * 2 + 1][j]));
                            const float g0 = __builtin_amdgcn_rcpf(__builtin_fmaf(e0, 1.0f / 255.0f, 1.0f / 255.0f)), g1 = __builtin_amdgcn_rcpf(__builtin_fmaf(e1, 1.0f / 255.0f, 1.0f / 255.0f));
                            w0 = __builtin_amdgcn_cvt_pk_u8_f32(fmaxf(g0, 1.0f), j, w0); w1 = __builtin_amdgcn_cvt_pk_u8_f32(fmaxf(g1, 1.0f), j, w1);
                        }
                        gb[bj].x = w0; gb[bj].y = w1;
                    }
                    unsigned char* gq = G8 + g8_tile(u.pm, u.pn - (C_GT - C_I8) / BM) + (wr * 4 + wc) * 8192 + (ai * 4 + m) * 1024 + (fq * 16 + fr) * 8;
                    __builtin_nontemporal_store(gb[0], (u32x2*)gq); __builtin_nontemporal_store(gb[1], (u32x2*)(gq + 512));
                }
            return;
        }
        f32x4 cq[4]; float sq[8];
        const float qs = mode == 2 ? 0.0625f * LOG2E : 1.0f;
#pragma unroll
        for (int k = 0; k < 4; ++k) { const u32x4 c_ = *(const u32x4*)(cmax + col0 + (k >> 1) * CBJ + (k & 1) * 4);
#pragma unroll
            for (int j = 0; j < 4; ++j) cq[k][j] = __uint_as_float(c_[j]) * qs; }
#pragma unroll
        for (int k = 0; k < 8; ++k) sq[k] = sa[rowg + (k >> 2) * HALF + (k & 3) * 16 + fr] * (1.0f / 127.0f);
#pragma unroll
        for (int ai = 0; ai < 2; ++ai)
#pragma unroll
            for (int m = 0; m < 4; ++m) {
                const float s = sq[ai * 4 + m];
                u32x4 pk[2];
#pragma unroll
                for (int bj = 0; bj < 2; ++bj) {
                    const v4i_t i0 = __builtin_bit_cast(v4i_t, acc[ai][bj][m][0]), i1 = __builtin_bit_cast(v4i_t, acc[ai][bj][m][1]);
                    f32x4 v0, v1;
#pragma unroll
                    for (int j = 0; j < 4; ++j) { v0[j] = (float)i0[j] * (s * cq[bj * 2][j]); v1[j] = (float)i1[j] * (s * cq[bj * 2 + 1][j]); }
                    pk[bj] = pack8(v0, v1);
                }
                store_pair(P + (size_t)(rowg + ai * HALF + m * 16) * INC + C_I8 + colw, INC, fr, fq, pk[0], pk[1]);
            }
    }
};
struct EpiUp {
    static constexpr bool PERM = true;
    bf16_t* H;
    __device__ __forceinline__ void operator()(f32x4 (&acc)[2][2][4][2], const Unit& u, int wr, int wc, int fr, int fq) const {
        const int rowg = u.pm * BM + wr * 64, colw = u.pn * BM + wc * 64;
#pragma unroll
        for (int ai = 0; ai < 2; ++ai)
#pragma unroll
            for (int m = 0; m < 4; ++m) {
                u32x4 pk[2];
#pragma unroll
                for (int bj = 0; bj < 2; ++bj) {
                    f32x4 v0 = acc[ai][bj][m][0], v1 = acc[ai][bj][m][1];
#pragma unroll
                    for (int j = 0; j < 4; ++j) { const float a = fmaxf(v0[j], 0.f), b = fmaxf(v1[j], 0.f); v0[j] = a * a; v1[j] = b * b; }
                    pk[bj] = pack8(v0, v1);
                }
                store_pair(H + (size_t)(rowg + ai * HALF + m * 16) * DFF + colw, DFF, fr, fq, pk[0], pk[1]);
            }
    }
};
struct EpiUp8 {
    static constexpr bool PERM = true, WIDE = true;
    unsigned char* ws; int l, tl;
#define UP8_CTL  ((unsigned*)(ws + WS_CTL))
#define UP8_H8   (ws + WS_PROJ)
#define UP8_SA   ((const float*)(ws + WS_SA))
#define UP8_CMAX ((const unsigned*)(ws + WS_CTL) + CW_CMAX + l * CM_L + NI8)
#define UP8_RMAX (UP8_CTL + CW_RMAX + l * MT)
#define UP8_RCNT (UP8_CTL + CW_RCNT)
#define UP8_TMO  (UP8_CTL + 4096 + 128)
#define UP8_TGT  (128u * (unsigned)tl)
    __device__ __forceinline__ void wait_posts(unsigned* cnt, unsigned have) const {
        const unsigned target = UP8_TGT; unsigned* tmo = UP8_TMO; unsigned sp = 0; while (have < target) { __builtin_amdgcn_s_sleep(1); have = __hip_atomic_load(cnt, __ATOMIC_RELAXED, __HIP_MEMORY_SCOPE_AGENT);
            if ((++sp & 255u) == 0u) { if (__hip_atomic_load(tmo, __ATOMIC_RELAXED, __HIP_MEMORY_SCOPE_AGENT)) break; if (sp > (1u << 18)) { atomicAdd(tmo, 1u); break; } } }
        asm volatile("" ::: "memory");
    }
    __device__ __forceinline__ void load_rmax(int pm, int wr, int fr_in, float (&rmv)[8]) const {
        int fr = fr_in; asm volatile("" : "+v"(fr));
        const unsigned* rp = UP8_RMAX + pm * BM + wr * 64 + fr;
#pragma unroll
        for (int k = 0; k < 8; ++k) rmv[k] = __uint_as_float(__hip_atomic_load(rp + (k >> 2) * HALF + (k & 3) * 16, __ATOMIC_RELAXED, __HIP_MEMORY_SCOPE_AGENT));
    }
    __device__ __forceinline__ void operator()(f32x4 (&acc)[2][2][4][2], const Unit& u, int wr, int wc, int fr_in, int fq_in, int wid, LAS unsigned char* lds) const {
        int fr = fr_in, fq = fq_in; asm volatile("" : "+v"(fr), "+v"(fq));
        const float* sa = UP8_SA; const unsigned* cmax = UP8_CMAX; unsigned* rmax = UP8_RMAX; unsigned* rcnt = UP8_RCNT;
        const int rowg = u.pm * BM + wr * 64, colw = u.pn * BM + wc * 64, lane = fq * 16 + fr;
        unsigned* pcnt = rcnt + u.pm * 32;
        LAS float* lmx = (LAS float*)(lds + MISC_OFF + 1024);
        float sv[8]; u32x4 cv[4];
#pragma unroll
        for (int k = 0; k < 8; ++k) sv[k] = sa[rowg + (k >> 2) * HALF + (k & 3) * 16 + fr] * (1.0f / 127.0f);
#pragma unroll
        for (int k = 0; k < 4; ++k) cv[k] = *(const u32x4*)(cmax + colw + 8 * fq + (k >> 1) * CBJ + (k & 1) * 4);
#pragma unroll
        for (int ai = 0; ai < 2; ++ai)
#pragma unroll
            for (int m = 0; m < 4; ++m) {
                const float s = sv[ai * 4 + m];
                float mx = 0.f;
#pragma unroll
                for (int bj = 0; bj < 2; ++bj) {
                    const v4i_t i0 = __builtin_bit_cast(v4i_t, acc[ai][bj][m][0]), i1 = __builtin_bit_cast(v4i_t, acc[ai][bj][m][1]);
                    const u32x4 c0_ = cv[bj * 2], c1_ = cv[bj * 2 + 1];
                    f32x4 v0, v1;
#pragma unroll
                    for (int j = 0; j < 4; ++j) { const float a = fmaxf((float)i0[j] * (s * __uint_as_float(c0_[j])), 0.f), b = fmaxf((float)i1[j] * (s * __uint_as_float(c1_[j])), 0.f); v0[j] = a * a; v1[j] = b * b; mx = fmaxf(mx, fmaxf(v0[j], v1[j])); }
                    acc[ai][bj][m][0] = v0; acc[ai][bj][m][1] = v1;
                }
                mx = fmaxf(mx, __shfl_xor(mx, 16)); mx = fmaxf(mx, __shfl_xor(mx, 32));
                if (fq == 0) lmx[wc * 256 + wr * 64 + ai * HALF + m * 16 + fr] = mx;
            }
        LDS_WAIT(); __builtin_amdgcn_s_barrier();
        if (wid < 4) {
            const int r = wid * 64 + lane;
            const float m4 = fmaxf(fmaxf(lmx[r], lmx[256 + r]), fmaxf(lmx[512 + r], lmx[768 + r]));
            const unsigned old = __hip_atomic_fetch_max(rmax + u.pm * BM + r, __float_as_uint(m4), __ATOMIC_RELAXED, __HIP_MEMORY_SCOPE_AGENT);
            asm volatile("" :: "v"(old) : "memory");
            if (lane == 0) (void)__hip_atomic_fetch_add(pcnt, 1u, __ATOMIC_RELAXED, __HIP_MEMORY_SCOPE_AGENT);
        }
        if (wid == 0) wait_posts(pcnt, __hip_atomic_load(pcnt, __ATOMIC_RELAXED, __HIP_MEMORY_SCOPE_AGENT));
        __builtin_amdgcn_s_barrier();
        LAS float* lfin = lmx + 1024;
        if (wid < 4) lfin[wid * 64 + lane] = __uint_as_float(__hip_atomic_load(rmax + u.pm * BM + wid * 64 + lane, __ATOMIC_RELAXED, __HIP_MEMORY_SCOPE_AGENT));
        LDS_WAIT(); __builtin_amdgcn_s_barrier();
        float rmv[8];
#pragma unroll
        for (int k = 0; k < 8; ++k) rmv[k] = lfin[wr * 64 + (k >> 2) * HALF + (k & 3) * 16 + fr];
        unsigned char* H8 = UP8_H8;
#pragma unroll
        for (int ai = 0; ai < 2; ++ai)
#pragma unroll
            for (int m = 0; m < 4; ++m) {
                const float rm = rmv[ai * 4 + m], inv = rm > 0.f ? 255.0f * __builtin_amdgcn_rcpf(rm) : 0.f;
                u32x2 gb[2];
#pragma unroll
                for (int bj = 0; bj < 2; ++bj) {
                    const f32x4 v0 = acc[ai][bj][m][0], v1 = acc[ai][bj][m][1];
                    unsigned w0 = 0u, w1 = 0u;
#pragma unroll
                    for (int j = 0; j < 4; ++j) { w0 = __builtin_amdgcn_cvt_pk_u8_f32(__builtin_rintf(v0[j] * inv), j, w0); w1 = __builtin_amdgcn_cvt_pk_u8_f32(__builtin_rintf(v1[j] * inv), j, w1); }
                    gb[bj].x = w0 ^ 0x80808080u; gb[bj].y = w1 ^ 0x80808080u;
                }
                store_pair8(H8 + (size_t)(rowg + ai * HALF + m * 16) * DFF + colw, DFF, fr, fq, gb[0], gb[1]);
            }
    }
#undef UP8_CTL
#undef UP8_H8
#undef UP8_SA
#undef UP8_CMAX
#undef UP8_RMAX
#undef UP8_RCNT
#undef UP8_TMO
#undef UP8_TGT
};
struct EpiY8 {
    static constexpr bool PERM = true;
    bf16_t* Y; float* ssy; float* yp; const unsigned* rmax; const unsigned* cmax; const int* csum;
    __device__ __forceinline__ void operator()(f32x4 (&acc)[2][2][4][2], const Unit& u, int wr, int wc, int fr, int fq) const {
        const int rowg = u.pm * BM + wr * 64, colw = u.pn * BM + wc * 64, row0 = rowg + fr, col0 = colw + 8 * fq;
        u32x4 cv[4]; v4i_t ov[4];
#pragma unroll
        for (int k = 0; k < 4; ++k) { cv[k] = *(const u32x4*)(cmax + col0 + (k >> 1) * CBJ + (k & 1) * 4); ov[k] = *(const v4i_t*)(csum + (u.ks < 0 ? 0 : (1 + u.ks) * DM) + col0 + (k >> 1) * CBJ + (k & 1) * 4); }
        float rv[8];
#pragma unroll
        for (int k = 0; k < 8; ++k) rv[k] = __uint_as_float(rmax[row0 + (k >> 2) * HALF + (k & 3) * 16]) * (1.0f / (255.0f * 127.0f));
#pragma unroll
        for (int ai = 0; ai < 2; ++ai)
#pragma unroll
            for (int m = 0; m < 4; ++m) {
                const int row = row0 + ai * HALF + m * 16;
                const float sr = rv[ai * 4 + m];
                float s = 0.f; u32x4 pk[2];
#pragma unroll
                for (int bj = 0; bj < 2; ++bj) {
                    const v4i_t i0 = __builtin_bit_cast(v4i_t, acc[ai][bj][m][0]) + ov[bj * 2], i1 = __builtin_bit_cast(v4i_t, acc[ai][bj][m][1]) + ov[bj * 2 + 1];
                    const u32x4 c0_ = cv[bj * 2], c1_ = cv[bj * 2 + 1];
                    f32x4 v0, v1;
#pragma unroll
                    for (int j = 0; j < 4; ++j) { v0[j] = (float)i0[j] * (sr * __uint_as_float(c0_[j])); v1[j] = (float)i1[j] * (sr * __uint_as_float(c1_[j])); }
                    s += (v0[0] * v0[0] + v0[1] * v0[1]) + (v0[2] * v0[2] + v0[3] * v0[3]) + (v1[0] * v1[0] + v1[1] * v1[1]) + (v1[2] * v1[2] + v1[3] * v1[3]);
                    pk[bj] = pack8(v0, v1);
                }
                if (u.ks >= 0) store_pair((bf16_t*)yp + ((size_t)u.ks * MS + (rowg - MP) + ai * HALF + m * 16) * DM + colw, DM, fr, fq, pk[0], pk[1]);
                else {
                    store_pair(Y + (size_t)(rowg + ai * HALF + m * 16) * DM + colw, DM, fr, fq, pk[0], pk[1]);
                    s += __shfl_xor(s, 16); s += __shfl_xor(s, 32);
                    if (fq == 0) ssy[(size_t)row * 32 + u.pn * 4 + wc] = s;
                }
            }
    }
};
struct EpiY {
    static constexpr bool PERM = true;
    bf16_t* Y; float* ssy; float* yp;
    __device__ __forceinline__ void operator()(f32x4 (&acc)[2][2][4][2], const Unit& u, int wr, int wc, int fr, int fq) const {
        const int rowg = u.pm * BM + wr * 64, colw = u.pn * BM + wc * 64, row0 = rowg + fr, col0 = colw + 8 * fq;
        if (u.ks >= 0) {
            bf16_t* base = (bf16_t*)yp + ((size_t)u.ks * MS + (rowg - MP)) * DM + colw;
#pragma unroll
            for (int ai = 0; ai < 2; ++ai)
#pragma unroll
                for (int m = 0; m < 4; ++m)
                    store_pair(base + (size_t)(ai * HALF + m * 16) * DM, DM, fr, fq, pack8(acc[ai][0][m][0], acc[ai][0][m][1]), pack8(acc[ai][1][m][0], acc[ai][1][m][1]));
            return;
        }
#pragma unroll
        for (int ai = 0; ai < 2; ++ai)
#pragma unroll
            for (int m = 0; m < 4; ++m) {
                const int row = row0 + ai * HALF + m * 16;
                float s = 0.f; u32x4 pk[2];
#pragma unroll
                for (int bj = 0; bj < 2; ++bj) {
                    const f32x4 v0 = acc[ai][bj][m][0], v1 = acc[ai][bj][m][1];
                    s += (v0[0] * v0[0] + v0[1] * v0[1]) + (v0[2] * v0[2] + v0[3] * v0[3]) + (v1[0] * v1[0] + v1[1] * v1[1]) + (v1[2] * v1[2] + v1[3] * v1[3]);
                    pk[bj] = pack8(v0, v1);
                }
                store_pair(Y + (size_t)(rowg + ai * HALF + m * 16) * DM + colw, DM, fr, fq, pk[0], pk[1]);
                s += __shfl_xor(s, 16); s += __shfl_xor(s, 32);
                if (fq == 0) ssy[(size_t)row * 32 + u.pn * 4 + wc] = s;
            }
    }
};
struct EpiBranch {
    static constexpr bool PERM = true;
    const unsigned char* G8; bf16_t* Mg;
    __device__ __forceinline__ void operator()(f32x4 (&acc)[2][2][4][2], const Unit& u, int wr, int wc, int fr, int fq) const {
        const int rowg = u.pm * BM + wr * 64, colw = u.pn * BM + wc * 64, row0 = rowg + fr, col0 = colw + 8 * fq, seg = u.seg;
        u32x2 gv[8][2], hv[8][2];
#pragma unroll
        for (int k = 0; k < 8; ++k) {
            const unsigned char* gp = G8 + g8_tile(u.pm, seg * 8 + u.pn) + (wr * 4 + wc) * 8192 + k * 1024 + (fq * 16 + fr) * 8;
#pragma unroll
            for (int bj = 0; bj < 2; ++bj) { gv[k][bj] = __builtin_nontemporal_load((const u32x2*)(gp + bj * 512)); if (seg < 2) hv[k][bj] = __builtin_nontemporal_load((const u32x2*)(gp + 8 * 65536 + bj * 512)); }
        }
#pragma unroll
        for (int ai = 0; ai < 2; ++ai)
#pragma unroll
            for (int m = 0; m < 4; ++m) {
                u32x4 pk[2];
#pragma unroll
                for (int bj = 0; bj < 2; ++bj) {
                    f32x4 g0, g1; unpack8u(gv[ai * 4 + m][bj], g0, g1);
                    if (seg < 2) {
                        f32x4 h0, h1; unpack8u(hv[ai * 4 + m][bj], h0, h1);
#pragma unroll
                        for (int j = 0; j < 4; ++j) { g0[j] = g0[j] * __builtin_amdgcn_rcpf(h0[j]); g1[j] = g1[j] * __builtin_amdgcn_rcpf(h1[j]); }
                        acc[ai][bj][m][0] = acc[ai][bj][m][0] * g0; acc[ai][bj][m][1] = acc[ai][bj][m][1] * g1;
                    } else pk[bj] = pack8(acc[ai][bj][m][0] * (g0 * (1.0f / 255.0f)), acc[ai][bj][m][1] * (g1 * (1.0f / 255.0f)));
                }
                if (seg == 2) store_pair(Mg + (size_t)(rowg + ai * HALF + m * 16) * DM + colw, DM, fr, fq, pk[0], pk[1]);
            }
    }
};
struct EpiPart {
    static constexpr bool PERM = true;
    float* bp;
    __device__ __forceinline__ void operator()(f32x4 (&acc)[2][2][4][2], const Unit& u, int wr, int wc, int fr, int fq) const {
        const int row0 = u.pm * BM + wr * 64 + fr, col0 = u.pn * BM + wc * 64 + 8 * fq;
        float* base = bp + ((size_t)u.seg * MS + (row0 - MP)) * DM + col0;
#pragma unroll
        for (int ai = 0; ai < 2; ++ai)
#pragma unroll
            for (int m = 0; m < 4; ++m)
#pragma unroll
                for (int bj = 0; bj < 2; ++bj) { float* op = base + (size_t)(ai * HALF + m * 16) * DM + bj * CBJ; *(f32x4*)op = acc[ai][bj][m][0]; *(f32x4*)(op + 4) = acc[ai][bj][m][1]; }
    }
};
struct EpiKV {
    static constexpr bool PERM = true;
    float* outk; float* outv; bf16_t* KP; bf16_t* VTP;
    __device__ __forceinline__ void operator()(f32x4 (&acc)[2][2][4][2], const Unit& u, int wr, int wc, int fr, int fq) const {
        const int row0 = u.pm * BM + wr * 64 + fr, l = u.pn >> 3, colL0 = (u.pn & 7) * BM + wc * 64 + 8 * fq;
        const bool isv = colL0 >= MW;
#pragma unroll
        for (int ai = 0; ai < 2; ++ai)
#pragma unroll
            for (int m = 0; m < 4; ++m) {
                const int row = row0 + ai * HALF + m * 16;
#pragma unroll
                for (int bj = 0; bj < 2; ++bj) {
                    const f32x4 v0 = acc[ai][bj][m][0], v1 = acc[ai][bj][m][1];
                    const int c = (colL0 + bj * CBJ) & (MW - 1);
                    float* op = (isv ? outv : outk) + (size_t)l * (512 * 1024) + (size_t)row * MW + c;
                    *(f32x4*)op = v0; *(f32x4*)(op + 4) = v1;
                    if (!isv) *(u32x4*)(KP + (size_t)l * (512 * 1024) + (size_t)row * MW + c) = pack8(v0, v1);
                    else {
                        const int b = row >> 8, key = row & 255, h = c >> 8, d = c & 255;
                        bf16_t* vp = VTP + ((size_t)((l * 2 + b) * 4 + h) * 256 + d) * 256 + key;
#pragma unroll
                        for (int j = 0; j < 4; ++j) { vp[(size_t)j * 256] = f2bf(v0[j]); vp[(size_t)(4 + j) * 256] = f2bf(v1[j]); }
                    }
                }
            }
    }
};
}

#define XB_TMO      128
#define XB_XCNT(j)  (256  + 64 * (j))
#define XB_XSUB(j)  (1280 + 64 * (j))
#define XB_XGEN(j)  (2304 + 64 * (j))
#define XB_TOP      3328
#define XB_TOPGEN   3392
#define XCD_BAR_WORDS 3456
#define XB_SPIN_CAP (1u << 18)
__device__ __forceinline__ unsigned xb_ld(unsigned* p)              { return __hip_atomic_load(p, __ATOMIC_RELAXED, __HIP_MEMORY_SCOPE_AGENT); }
__device__ __forceinline__ unsigned xb_add(unsigned* p, unsigned v) { return __hip_atomic_fetch_add(p, v, __ATOMIC_RELAXED, __HIP_MEMORY_SCOPE_AGENT); }
__device__ __forceinline__ unsigned xb_xcc_id() { return (unsigned)__builtin_amdgcn_s_getreg((3 << 11) | 20) & 0xFu; }
#define XB_SPIN(cond, bar) do { unsigned _sp = 0; while (cond) { __builtin_amdgcn_s_sleep(1); \
    if ((++_sp & 255u) == 0u) { if (xb_ld(&(bar)[XB_TMO])) break; if (_sp > XB_SPIN_CAP) { atomicAdd(&(bar)[XB_TMO], 1u); break; } } } } while (0)
struct XcdBarrier { unsigned* bar; unsigned x; volatile LAS unsigned* st; };
__device__ __forceinline__ XcdBarrier xcd_barrier_post(unsigned* bar, volatile LAS unsigned* st) {
    XcdBarrier b; b.bar = bar; b.x = xb_xcc_id(); b.st = st;
    if (threadIdx.x == 0) (void)xb_add(&bar[XB_XCNT(b.x)], 1u);
    return b;
}
__device__ __forceinline__ void xcd_barrier_complete(unsigned* bar, unsigned x, unsigned& nloc, unsigned& nx) {
    const unsigned G = gridDim.x * gridDim.y * gridDim.z;
    unsigned sum, cnt, mine, sp = 0u;
    for (;;) {
        sum = 0u; cnt = 0u; mine = 0u;
#pragma unroll
        for (unsigned j = 0; j < 16; ++j) { const unsigned c = xb_ld(&bar[XB_XCNT(j)]); sum += c; cnt += (c > 0u) ? 1u : 0u; mine = (j == x) ? c : mine; }
        if (sum == G) break;
        __builtin_amdgcn_s_sleep(1);
        if ((++sp & 255u) == 0u) { if (xb_ld(&bar[XB_TMO])) break; if (sp > XB_SPIN_CAP) { atomicAdd(&bar[XB_TMO], 1u); break; } }
    }
    nloc = mine > 0u ? mine : 1u; nx = cnt > 0u ? cnt : 1u;
}
__device__ __forceinline__ void xcd_barrier(const XcdBarrier& b) {
    asm volatile("s_waitcnt vmcnt(0)" ::: "memory");
    __syncthreads();
    if (threadIdx.x == 0) {
        unsigned* bar = b.bar;
        __builtin_amdgcn_s_waitcnt(0);
        unsigned nloc = b.st[0], nx = b.st[1];
        if (nloc == 0u) { xcd_barrier_complete(bar, b.x, nloc, nx); b.st[0] = nloc; b.st[1] = nx; }
        const unsigned old = xb_add(&bar[XB_XSUB(b.x)], 1u);
        const unsigned gen = old / nloc;
        if (old + 1u == (gen + 1u) * nloc) {
            __builtin_amdgcn_fence(__ATOMIC_RELEASE, "agent");
            asm volatile("s_waitcnt vmcnt(0)" ::: "memory");
            const unsigned og = xb_add(&bar[XB_TOP], 1u);
            const unsigned tg = og / nx;
            if (og + 1u == (tg + 1u) * nx) xb_add(&bar[XB_TOPGEN], 1u);
            else XB_SPIN(xb_ld(&bar[XB_TOPGEN]) == tg, bar);
            __builtin_amdgcn_fence(__ATOMIC_ACQUIRE, "agent");
            xb_add(&bar[XB_XGEN(b.x)], 1u);
            asm volatile("s_waitcnt vmcnt(0)" ::: "memory");
        } else {
            XB_SPIN(xb_ld(&bar[XB_XGEN(b.x)]) == gen, bar);
            __builtin_amdgcn_fence(__ATOMIC_ACQUIRE, "agent");
            asm volatile("s_waitcnt vmcnt(0)" ::: "memory");
        }
    }
    __syncthreads();
}

struct TItem { const float* W; bf16_t* WT; const float* scale; int K, N, r, nblk, noff, kind; const unsigned* cmax; int* csum; };
__device__ __forceinline__ void titem_load(const TItem& t, f32x4 (&x)[16], float (&sc)[16], int lane) {
    const int nblk = t.nblk, kb = t.r / nblk, nb = t.r - kb * nblk, k0 = 64 * kb, n0 = t.noff + 64 * nb, c = lane & 15, r = lane >> 4;
#pragma unroll
    for (int i = 0; i < 16; ++i) { const int kk = t.kind ? 16 * (i >> 2) + 4 * r + (i & 3) : 8 * (i >> 1) + 2 * r + (i & 1); x[i] = __builtin_nontemporal_load((const f32x4*)(t.W + (size_t)(k0 + kk) * t.N + n0 + 4 * c)); sc[i] = t.scale ? t.scale[k0 + kk] : 1.0f; }
}
__device__ __forceinline__ void titem_finish(const TItem& t, const f32x4 (&x)[16], const float (&sc)[16], LAS float* scr_f, int lane) {
    LAS unsigned* scr = (LAS unsigned*)scr_f;
    const int nblk = t.nblk, kb = t.r / nblk, nb = t.r - kb * nblk, k0 = 64 * kb, n0 = t.noff + 64 * nb, c = lane & 15, r = lane >> 4;
    if (t.kind) {
        float inv[4];
#pragma unroll
        for (int e = 0; e < 4; ++e) inv[e] = 127.0f / fmaxf(__uint_as_float(t.cmax[n0 - t.noff + 4 * c + e]), 1e-30f);
#pragma unroll
        for (int p = 0; p < 4; ++p)
#pragma unroll
            for (int e = 0; e < 4; ++e) {
                unsigned w = 0;
#pragma unroll
                for (int j = 0; j < 4; ++j) { const float v = __builtin_amdgcn_fmed3f(__builtin_rintf(x[4 * p + j][e] * sc[4 * p + j] * inv[e]), -127.f, 127.f); w |= ((unsigned)(int)v & 255u) << (8 * j); }
                scr[(4 * c + e) * 17 + 4 * p + r] = w;
            }
        LDS_WAIT(); asm volatile("" ::: "memory");
        const int q4 = lane & 3;
#pragma unroll
        for (int j = 0; j < 4; ++j) { const int n = (lane >> 2) + 16 * j; const LAS unsigned* s = scr + n * 17 + 4 * q4;
            u32x4 o; o.x = s[0]; o.y = s[1]; o.z = s[2]; o.w = s[3];
            *(u32x4*)((unsigned char*)t.WT + (size_t)(n0 - t.noff + n) * t.K + k0 + 16 * q4) = o;
            if (t.csum) {
                int cs = __builtin_amdgcn_sdot4((int)o.x, 0x01010101, 0, false); cs = __builtin_amdgcn_sdot4((int)o.y, 0x01010101, cs, false); cs = __builtin_amdgcn_sdot4((int)o.z, 0x01010101, cs, false); cs = __builtin_amdgcn_sdot4((int)o.w, 0x01010101, cs, false);
                cs += __shfl_xor(cs, 1); cs += __shfl_xor(cs, 2);
                if (q4 == 0) { atomicAdd(t.csum + n0 - t.noff + n, cs * 128); atomicAdd(t.csum + (1 + (k0 >> 10)) * DM + n0 - t.noff + n, cs * 128); }
            } }
        LDS_WAIT(); asm volatile("" ::: "memory");
        return;
    }
#pragma unroll
    for (int p = 0; p < 8; ++p)
#pragma unroll
        for (int e = 0; e < 4; ++e) scr[(4 * c + e) * 33 + 4 * p + r] = cvtpk(x[2 * p][e] * sc[2 * p], x[2 * p + 1][e] * sc[2 * p + 1]);
    LDS_WAIT(); asm volatile("" ::: "memory");
    const int q = lane & 7;
#pragma unroll
    for (int j = 0; j < 8; ++j) { const int n = (lane >> 3) + 8 * j; const LAS unsigned* s = scr + n * 33 + 4 * q;
        u32x4 o; o.x = s[0]; o.y = s[1]; o.z = s[2]; o.w = s[3];
        *(u32x4*)(t.WT + (size_t)(n0 + n) * t.K + k0 + 8 * q) = o; }
    LDS_WAIT(); asm volatile("" ::: "memory");
}
__device__ __forceinline__ void row_quant8(const f32x4 (&n0)[4], const f32x4 (&n1)[4], float mul, unsigned char* qrow, float* sa, int lane) {
    float am = 0.f;
#pragma unroll
    for (int j = 0; j < 4; ++j)
#pragma unroll
        for (int e = 0; e < 4; ++e) am = fmaxf(am, fmaxf(__builtin_fabsf(n0[j][e]), __builtin_fabsf(n1[j][e])));
#pragma unroll
    for (int o = 1; o < 64; o <<= 1) am = fmaxf(am, __shfl_xor(am, o));
    am *= mul;
    const float inv = am > 0.f ? 127.0f / am : 0.f, k = inv * mul;
#pragma unroll
    for (int j = 0; j < 4; ++j) {
        u32x2 w; w.x = 0; w.y = 0;
#pragma unroll
        for (int e = 0; e < 4; ++e) { const float a = __builtin_amdgcn_fmed3f(__builtin_rintf(n0[j][e] * k), -127.f, 127.f), b = __builtin_amdgcn_fmed3f(__builtin_rintf(n1[j][e] * k), -127.f, 127.f);
            w.x |= ((unsigned)(int)a & 255u) << (8 * e); w.y |= ((unsigned)(int)b & 255u) << (8 * e); }
        *(u32x2*)(qrow + j * 512 + lane * 8) = w;
    }
    if (lane == 0) *sa = am * (1.0f / 127.0f);
}

__device__ __forceinline__ float row_to_bf16_normed(const float* xrow, bf16_t* orow, int lane, unsigned char* qrow = nullptr, float* sa = nullptr) {
    f32x4 a[4], b[4]; float ss = 0.f;
#pragma unroll
    for (int j = 0; j < 4; ++j) {
        a[j] = *(const f32x4*)(xrow + j * 512 + lane * 8); b[j] = *(const f32x4*)(xrow + j * 512 + lane * 8 + 4);
        ss += (a[j][0] * a[j][0] + a[j][1] * a[j][1]) + (a[j][2] * a[j][2] + a[j][3] * a[j][3]) + (b[j][0] * b[j][0] + b[j][1] * b[j][1]) + (b[j][2] * b[j][2] + b[j][3] * b[j][3]);
    }
    const float ms = wave_sum(ss) * (1.0f / DM) + EPS, rs = __builtin_amdgcn_rsqf(ms);
#pragma unroll
    for (int j = 0; j < 4; ++j) *(u32x4*)(orow + j * 512 + lane * 8) = pack8(a[j] * rs, b[j] * rs);
    if (qrow) row_quant8(a, b, rs, qrow, sa, lane);
    return __builtin_sqrtf(ms);
}

struct Args { const float* in[30]; float* out; unsigned char* ws; int ph_lo, ph_hi; };
enum { I_XP = 0, I_XS, I_MEM, I_SLH, I_SLC, I_SSC, I_CK, I_CV, I_GMIXPRE, I_WIN, I_BGATE, I_LCW, I_LCB, I_LWA, I_LBA, I_LWI, I_LBI, I_LAM, I_WBL, I_SCW, I_WBC, I_GMEM, I_WKV, I_WBM, I_WOUT,
       I_GMIXPOST, I_GMLPPRE, I_WUP, I_WDN, I_GMLPPOST };
constexpr int NPH = 1 + 9 * DEPTH;
constexpr int CV_B = 7800;

constexpr int IT_IN = (DM / 64) * (INC / 64), IT_BR = (1024 / 64) * (DM / 64), IT_OUT = (DM / 64) * (DM / 64), IT_UP = (DM / 64) * (DFF / 64), IT_DN = (DFF / 64) * (DM / 64), IT_KV = IT_OUT;
constexpr int IT_LW = IT_IN + 3 * IT_BR + IT_OUT + IT_UP + IT_DN, IT_W = DEPTH * IT_LW, IT_KVA = DEPTH * IT_KV, IT_V = (MEMLEN / 64) * (MW / 64), IT_ALL = IT_W + IT_KVA;
template <bool FULL> __device__ __forceinline__ TItem decode_item(const Args& args, int it) {
    unsigned char* ws = args.ws; TItem t;
    if (FULL) if (it >= IT_W + IT_KVA) { const int v = it - IT_W - IT_KVA, mb = v / IT_V; t.W = args.in[I_CV] + (size_t)mb * MEMLEN * MW; t.K = MEMLEN; t.N = MW; t.nblk = MW / 64; t.noff = 0; t.kind = 0; t.cmax = nullptr; t.csum = nullptr; t.WT = (bf16_t*)(ws + WS_VTS) + (size_t)mb * MEMLEN * MW; t.scale = nullptr; t.r = v - mb * IT_V; return t; }
    if (FULL) if (it >= IT_W) { const int v = it - IT_W, l = v / IT_KV; t.W = args.in[I_WKV] + (size_t)l * DM * DM; t.K = DM; t.N = DM; t.nblk = DM / 64; t.noff = 0; t.kind = 0; t.cmax = nullptr; t.csum = nullptr; t.WT = (bf16_t*)(ws + WS_WKV + l * SZ_WOUT); t.scale = args.in[I_GMEM] + l * DM; t.r = v - l * IT_KV; return t; }
    const int l = it / IT_LW; int r = it - l * IT_LW;
    t.noff = 0; t.kind = 0; t.cmax = nullptr; t.csum = nullptr;
    if (r < IT_IN) {
        constexpr int IT_INB = (DM / 64) * (C_I8 / 64);
        const bool q = r >= IT_INB;
        t.W = args.in[I_WIN] + (size_t)l * DM * INC; t.K = DM; t.N = INC; t.nblk = q ? NI8 / 64 : C_I8 / 64; t.scale = args.in[I_GMIXPRE] + l * DM; t.r = q ? r - IT_INB : r;
        t.noff = q ? C_I8 : 0; t.kind = q ? 1 : 0; t.WT = (bf16_t*)(ws + WS_WIN + l * SZ_WIN + (q ? WQ_OFF : 0));
        t.cmax = (const unsigned*)(ws + WS_CTL) + CW_CMAX + l * CM_L;
        return t; } r -= IT_IN;
    if (r < 3 * IT_BR) { const int s = r / IT_BR; t.W = args.in[s == 0 ? I_WBL : (s == 1 ? I_WBC : I_WBM)] + (size_t)l * 1024 * DM; t.K = 1024; t.N = DM; t.nblk = DM / 64; t.WT = (bf16_t*)(ws + WS_WBR + (l * 3 + s) * SZ_WBR1); t.scale = nullptr; t.r = r - s * IT_BR; return t; } r -= 3 * IT_BR;
    if (r < IT_OUT) { t.W = args.in[I_WOUT] + (size_t)l * DM * DM; t.K = DM; t.N = DM; t.nblk = DM / 64; t.WT = (bf16_t*)(ws + WS_WOUT + l * SZ_WOUT); t.scale = nullptr; t.r = r; return t; } r -= IT_OUT;
    if (r < IT_UP) { t.W = args.in[I_WUP] + (size_t)l * DM * DFF; t.K = DM; t.N = DFF; t.nblk = DFF / 64; t.WT = (bf16_t*)(ws + WS_WUP + l * SZ_WUP); t.scale = args.in[I_GMLPPRE] + l * DM; t.r = r; t.kind = 1; t.cmax = (const unsigned*)(ws + WS_CTL) + CW_CMAX + l * CM_L + NI8; return t; } r -= IT_UP;
    t.W = args.in[I_WDN] + (size_t)l * DFF * DM; t.K = DFF; t.N = DM; t.nblk = DM / 64; t.WT = (bf16_t*)(ws + WS_WDN + l * SZ_WUP); t.scale = nullptr; t.r = r; t.kind = 1;
    t.cmax = (const unsigned*)(ws + WS_CTL) + CW_CMAX + l * CM_L + NI8 + DFF; t.csum = (int*)(ws + WS_CTL) + cw_csum9(l); return t;
}
template <bool FULL> __device__ __forceinline__ void conv_stream(const Args& args, LAS float* scr, int lane_in, int it0, int it1, int w, int nw, int jump_at = 0x7fffffff, int jump_by = 0) {
    int lane = lane_in; asm volatile("" : "+v"(lane));
    int it = it0 + w;
    if (it >= it1) return;
    TItem cur = decode_item<FULL>(args, it < jump_at ? it : it + jump_by); f32x4 xc[16]; float sc[16];
    titem_load(cur, xc, sc, lane);
    for (;;) {
        const int nit = it + nw; const bool more = nit < it1;
        TItem nxt = cur; f32x4 xn[16]; float sn[16];
        if (more) { nxt = decode_item<FULL>(args, nit < jump_at ? nit : nit + jump_by); titem_load(nxt, xn, sn, lane); }
        titem_finish(cur, xc, sc, scr, lane);
        if (!more) break;
#pragma unroll
        for (int i = 0; i < 16; ++i) { xc[i] = xn[i]; sc[i] = sn[i]; }
        cur = nxt; it = nit;
    }
}

template <bool FINAL, bool SMP>
__device__ __forceinline__ void lru_unit(const Args& args, int l, int p, int h, LAS unsigned char* lds, int wave, int lane) {
    asm volatile("" : "+v"(lane));
    unsigned char* ws = args.ws;
    const bf16_t* PROJ = (const bf16_t*)(ws + WS_PROJ);
    const int r16 = lane & 15, g = lane >> 4;
    const int b = SMP ? (p - 64) * 8 + wave : (p >> 5);
    const int t0 = SMP ? 0 : ((p & 31) * 256 + 32 * wave);
    const int R0 = p * 256 + 32 * wave;
    LAS float* WA = (LAS float*)lds; LAS float* WB = WA + 8 * 64; LAS float* HIN = WB + 8 * 64;
    u32x4 xr[2][2][4];
    f32x4 cwv[2][4][2], cbv[2][2];
    {
        const float* cw = args.in[I_LCW] + (size_t)l * 4 * LW; const float* cb = args.in[I_LCB] + (size_t)l * LW;
#pragma unroll
        for (int ks = 0; ks < 2; ++ks) {
            const int c0 = h * 64 + 32 * ks + 8 * g;
#pragma unroll
            for (int mt = 0; mt < 2; ++mt)
#pragma unroll
                for (int k = 0; k < 4; ++k) { const int rr = R0 + 16 * mt + r16 + k - 3; const bf16_t* src = PROJ + (size_t)(rr < 0 ? 0 : rr) * INC + C_LX + c0;
                    if (SMP && mt == 0 && k < 3) { const int ts = r16 + k - 3; const bf16_t* alt = (const bf16_t*)(ws + WS_SLCB) + ((size_t)(l * DBATCH + b) * 3 + (ts < 0 ? 3 + ts : 0)) * LW + c0; src = ts < 0 ? alt : src; }
                    xr[ks][mt][k] = *(const u32x4*)src; }
#pragma unroll
            for (int k = 0; k < 4; ++k) { cwv[ks][k][0] = *(const f32x4*)(cw + k * LW + c0); cwv[ks][k][1] = *(const f32x4*)(cw + k * LW + c0 + 4); }
            cbv[ks][0] = *(const f32x4*)(cb + c0); cbv[ks][1] = *(const f32x4*)(cb + c0 + 4);
        }
    }
    bf16x8 Af[2][2];
#pragma unroll
        for (int mt = 0; mt < 2; ++mt) {
            f32x4 u0 = cbv[0][0], u1 = cbv[0][1];
#pragma unroll
            for (int k = 0; k < 4; ++k) {
                const int ts = t0 + 16 * mt + r16 + k - 3;
                f32x4 x0, x1; unpack8(xr[0][mt][k], x0, x1);
                if (!SMP) { const float keep = ts < 0 ? 0.f : 1.f; x0 = x0 * keep; x1 = x1 * keep; }
                u0 += cwv[0][k][0] * x0; u1 += cwv[0][k][1] * x1;
            }
            Af[mt][0] = __builtin_bit_cast(bf16x8, pack8(u0, u1));
        }
    asm volatile("" ::: "memory");
    bf16x8 fa[4][2], fi[4][2];
    float bav[4], biv[4], lamv[4];
    {
        const bf16_t* WAT = (const bf16_t*)(ws + WS_WAT) + ((size_t)(l * LHEADS + h) * 64) * 64;
        const bf16_t* WIT = (const bf16_t*)(ws + WS_WIT) + ((size_t)(l * LHEADS + h) * 64) * 64;
        const float* ba = args.in[I_LBA] + (size_t)l * LW; const float* bi = args.in[I_LBI] + (size_t)l * LW; const float* c8t = (const float*)(ws + WS_PA) + (size_t)l * LW;
#pragma unroll
        for (int nt = 0; nt < 4; ++nt) {
#pragma unroll
            for (int ks = 0; ks < 2; ++ks) { const int n = 16 * nt + r16, k0 = 32 * ks + 8 * g; fa[nt][ks] = *(const bf16x8*)(WAT + n * 64 + k0); fi[nt][ks] = *(const bf16x8*)(WIT + n * 64 + k0); }
            const int ch = h * 64 + 16 * nt + r16; bav[nt] = ba[ch]; biv[nt] = bi[ch]; lamv[nt] = c8t[ch];
        }
    }
    asm volatile("" ::: "memory");
#pragma unroll
        for (int mt = 0; mt < 2; ++mt) {
            f32x4 u0 = cbv[1][0], u1 = cbv[1][1];
#pragma unroll
            for (int k = 0; k < 4; ++k) {
                const int ts = t0 + 16 * mt + r16 + k - 3;
                f32x4 x0, x1; unpack8(xr[1][mt][k], x0, x1);
                if (!SMP) { const float keep = ts < 0 ? 0.f : 1.f; x0 = x0 * keep; x1 = x1 * keep; }
                u0 += cwv[1][k][0] * x0; u1 += cwv[1][k][1] * x1;
            }
            Af[mt][1] = __builtin_bit_cast(bf16x8, pack8(u0, u1));
        }
    f32x4 Da[2][4], Di[2][4], Du[2][4];
#pragma unroll
    for (int nt = 0; nt < 4; ++nt) {
#pragma unroll
        for (int mt = 0; mt < 2; ++mt) { Da[mt][nt] = (f32x4){0.f, 0.f, 0.f, 0.f}; Di[mt][nt] = Da[mt][nt]; Du[mt][nt] = Da[mt][nt]; }
#pragma unroll
        for (int ks = 0; ks < 2; ++ks) {
            const int n = 16 * nt + r16, k0 = 32 * ks + 8 * g;
            bf16x8 id;
#pragma unroll
            for (int j = 0; j < 8; ++j) id[j] = (k0 + j == n) ? (short)0x3F80 : (short)0;
#pragma unroll
            for (int mt = 0; mt < 2; ++mt) {
                Da[mt][nt] = __builtin_amdgcn_mfma_f32_16x16x32_bf16(Af[mt][ks], fa[nt][ks], Da[mt][nt], 0, 0, 0);
                Di[mt][nt] = __builtin_amdgcn_mfma_f32_16x16x32_bf16(Af[mt][ks], fi[nt][ks], Di[mt][nt], 0, 0, 0);
                Du[mt][nt] = __builtin_amdgcn_mfma_f32_16x16x32_bf16(Af[mt][ks], id, Du[mt][nt], 0, 0, 0);
            }
        }
    }
    float totA[4], totB[4];
#pragma unroll
    for (int nt = 0; nt < 4; ++nt) {
        const float c8 = lamv[nt];
        float cA = 1.f, cB = 0.f;
#pragma unroll
        for (int mt = 0; mt < 2; ++mt) {
            float av[4], bv[4];
#pragma unroll
            for (int j = 0; j < 4; ++j) {
                const float r = fsigmoid(Da[mt][nt][j] + bav[nt]), ig = fsigmoid(Di[mt][nt][j] + biv[nt]);
                const float a = __builtin_amdgcn_exp2f(-LOG2E * c8 * r);
                av[j] = a; bv[j] = __builtin_amdgcn_sqrtf(fmaxf(1.0f - a * a, 0.f)) * (ig * Du[mt][nt][j]);
            }
            float pA[4], pB[4];
            pA[0] = av[0]; pB[0] = bv[0];
#pragma unroll
            for (int j = 1; j < 4; ++j) { pA[j] = pA[j - 1] * av[j]; pB[j] = av[j] * pB[j - 1] + bv[j]; }
            float tA[4], tB[4];
#pragma unroll
            for (int gg = 0; gg < 4; ++gg) { tA[gg] = __shfl(pA[3], r16 + 16 * gg); tB[gg] = __shfl(pB[3], r16 + 16 * gg); }
            float eA = cA, eB = cB;
#pragma unroll
            for (int gg = 0; gg < 3; ++gg) { const bool on = gg < g; const float nB = tA[gg] * eB + tB[gg], nA = eA * tA[gg]; eB = on ? nB : eB; eA = on ? nA : eA; }
#pragma unroll
            for (int j = 0; j < 4; ++j) { Da[mt][nt][j] = eA * pA[j]; Di[mt][nt][j] = pA[j] * eB + pB[j]; }
#pragma unroll
            for (int gg = 0; gg < 4; ++gg) { cB = tA[gg] * cB + tB[gg]; cA = cA * tA[gg]; }
        }
        totA[nt] = cA; totB[nt] = cB;
    }
    if (!FINAL) {
        if (g == 0) {
#pragma unroll
            for (int nt = 0; nt < 4; ++nt) { WA[wave * 64 + 16 * nt + r16] = totA[nt]; WB[wave * 64 + 16 * nt + r16] = totB[nt]; }
        }
        __syncthreads();
        if (wave == 0) {
            float A = 1.f, B = 0.f;
#pragma unroll
            for (int w = 0; w < 8; ++w) { const float a = WA[w * 64 + lane], bq = WB[w * 64 + lane]; B = a * B + bq; A = A * a; }
            float* PA = (float*)(ws + WS_PA); float* PB = (float*)(ws + WS_PB);
            const size_t o = ((size_t)b * 32 + (p & 31)) * LW + h * 64 + lane;
            PA[o] = A; PB[o] = B;
        }
        __syncthreads();
        return;
    }
    float hs[4];
    if (SMP) {
        const float* h0 = args.in[I_SLH] + ((size_t)l * DBATCH + b) * LW;
#pragma unroll
        for (int nt = 0; nt < 4; ++nt) hs[nt] = h0[h * 64 + 16 * nt + r16];
    } else {
        if (g == 0) {
#pragma unroll
            for (int nt = 0; nt < 4; ++nt) { WA[wave * 64 + 16 * nt + r16] = totA[nt]; WB[wave * 64 + 16 * nt + r16] = totB[nt]; }
        }
        __syncthreads();
        {
            typedef unsigned long long u64;
            const unsigned tag = (unsigned)l + 1u; const int np = p & 31;
            u64* gr = (u64*)(ws + WS_GRAN) + ((size_t)(b * 32) * LW + h * 64 + lane) * 2;
            if (wave == 0) {
                float A = 1.f, B = 0.f;
#pragma unroll
                for (int w = 0; w < 8; ++w) { const float a = WA[w * 64 + lane], bq = WB[w * 64 + lane]; B = a * B + bq; A = A * a; }
                __hip_atomic_store(gr + (size_t)np * LW * 2, ((u64)tag << 32) | __float_as_uint(A), __ATOMIC_RELAXED, __HIP_MEMORY_SCOPE_AGENT);
                __hip_atomic_store(gr + (size_t)np * LW * 2 + 1, ((u64)tag << 32) | __float_as_uint(B), __ATOMIC_RELAXED, __HIP_MEMORY_SCOPE_AGENT);
            }
            float pA = 1.f, pB = 0.f;
            if (4 * wave < np) {
                u64 va[4], vb[4]; unsigned spins = 0;
                for (;;) {
                    bool ok = true;
#pragma unroll
                    for (int k = 0; k < 4; ++k) { const int q = (4 * wave + k < np) ? 4 * wave + k : 4 * wave;
                        va[k] = __hip_atomic_load(gr + (size_t)q * LW * 2, __ATOMIC_RELAXED, __HIP_MEMORY_SCOPE_AGENT); vb[k] = __hip_atomic_load(gr + (size_t)q * LW * 2 + 1, __ATOMIC_RELAXED, __HIP_MEMORY_SCOPE_AGENT); }
#pragma unroll
                    for (int k = 0; k < 4; ++k) ok = ok && (unsigned)(va[k] >> 32) == tag && (unsigned)(vb[k] >> 32) == tag;
                    if (__all(ok) || ++spins > (1u << 16)) break;
                    __builtin_amdgcn_s_sleep(2);
                }
#pragma unroll
                for (int k = 0; k < 4; ++k) if (4 * wave + k < np) { const float a = __uint_as_float((unsigned)va[k]), bq = __uint_as_float((unsigned)vb[k]); pB = a * pB + bq; pA = pA * a; }
            }
            HIN[wave * 64 + lane] = pA; HIN[512 + wave * 64 + lane] = pB;
        }
        __syncthreads();
#pragma unroll
        for (int nt = 0; nt < 4; ++nt) {
            const int c = 16 * nt + r16; float hv = 0.f;
#pragma unroll
            for (int w = 0; w < 8; ++w) hv = HIN[w * 64 + c] * hv + HIN[512 + w * 64 + c];
#pragma unroll
            for (int w = 0; w < 7; ++w) { const float nv = WA[w * 64 + c] * hv + WB[w * 64 + c]; hv = w < wave ? nv : hv; }
            hs[nt] = hv;
        }
    }
    bf16_t gt[2][4][4];
    const unsigned go0 = (unsigned)(((R0 + 4 * g) * INC + C_LG + h * 64 + r16) * 2);
    const unsigned so0 = (unsigned)(((R0 + 4 * g) * LW + h * 64 + r16) * 2);
    asm volatile("" ::: "memory");
    if (FINAL) {
#pragma unroll
        for (int nt = 0; nt < 4; ++nt)
#pragma unroll
            for (int mt = 0; mt < 2; ++mt)
#pragma unroll
                for (int j = 0; j < 4; ++j) gt[mt][nt][j] = *(const bf16_t*)((const char*)PROJ + (go0 + (unsigned)((16 * mt + j) * (INC * 2) + 32 * nt)));
    }
    bf16_t* ALRU = (bf16_t*)(ws + WS_ABR);
    const bool lastw = SMP || ((p & 31) == 31 && wave == 7);
    float* hout = SMP ? args.out + O_SLH + ((size_t)l * DBATCH + b) * LW : args.out + O_PLH + ((size_t)l * NBATCH + b) * LW;
#pragma unroll
    for (int nt = 0; nt < 4; ++nt) {
        const int ch = h * 64 + 16 * nt + r16;
#pragma unroll
        for (int mt = 0; mt < 2; ++mt)
#pragma unroll
            for (int j = 0; j < 4; ++j) {
                const float hv = Da[mt][nt][j] * hs[nt] + Di[mt][nt][j];
                *(bf16_t*)((char*)ALRU + (so0 + (unsigned)((16 * mt + j) * (LW * 2) + 32 * nt))) = f2bf(hv * bf1(gt[mt][nt][j]));
                if (lastw && mt == 1 && j == 3 && g == 3) hout[ch] = hv;
            }
    }
    if (!SMP) __syncthreads();
}

__device__ __forceinline__ void sconv_item(const Args& args, int l, int item, int lane) {
    asm volatile("" : "+v"(lane));
    unsigned char* ws = args.ws;
    const bf16_t* PROJ = (const bf16_t*)(ws + WS_PROJ); bf16_t* ACONV = (bf16_t*)(ws + WS_ABR + SZ_ABR1);
    const int tb = item >> 1, c0 = (item & 1) * 512 + lane * 8, row0 = tb * 8;
    const bool smp = row0 >= MP;
    const int b = smp ? (row0 - MP) / DSEQ : row0 / SEQ, t0 = smp ? (row0 - MP) % DSEQ : row0 % SEQ, T = smp ? DSEQ : SEQ;
    const float* cw = args.in[I_SCW] + (size_t)l * 3 * LW + c0;
    f32x4 w[3][2];
#pragma unroll
    for (int k = 0; k < 3; ++k) { w[k][0] = *(const f32x4*)(cw + k * LW); w[k][1] = *(const f32x4*)(cw + k * LW + 4); }
    f32x4 zm2[2], zm1[2];
    if (t0 > 0) {
        f32x4 a0, a1, b0, b1;
        unpack8(*(const u32x4*)(PROJ + (size_t)(row0 - 2) * INC + C_SC + c0), a0, a1); unpack8(*(const u32x4*)(PROJ + (size_t)(row0 - 2) * INC + C_SH + c0), b0, b1); zm2[0] = a0 * b0; zm2[1] = a1 * b1;
        unpack8(*(const u32x4*)(PROJ + (size_t)(row0 - 1) * INC + C_SC + c0), a0, a1); unpack8(*(const u32x4*)(PROJ + (size_t)(row0 - 1) * INC + C_SH + c0), b0, b1); zm1[0] = a0 * b0; zm1[1] = a1 * b1;
    } else if (smp) {
        const float* sb = args.in[I_SSC] + ((size_t)l * DBATCH + b) * 2 * LW + c0;
        zm2[0] = *(const f32x4*)sb; zm2[1] = *(const f32x4*)(sb + 4); zm1[0] = *(const f32x4*)(sb + LW); zm1[1] = *(const f32x4*)(sb + LW + 4);
    } else { zm2[0] = (f32x4){0.f, 0.f, 0.f, 0.f}; zm2[1] = zm2[0]; zm1[0] = zm2[0]; zm1[1] = zm2[0]; }
#pragma unroll
    for (int i = 0; i < 8; ++i) {
        const bf16_t* pr = PROJ + (size_t)(row0 + i) * INC + c0;
        f32x4 a0, a1, b0, b1, s0, s1;
        unpack8(*(const u32x4*)(pr + C_SC), a0, a1); unpack8(*(const u32x4*)(pr + C_SH), b0, b1); unpack8(*(const u32x4*)(pr + C_SB), s0, s1);
        const f32x4 z0 = a0 * b0, z1 = a1 * b1;
        const f32x4 cv0 = w[0][0] * zm2[0] + w[1][0] * zm1[0] + w[2][0] * z0, cv1 = w[0][1] * zm2[1] + w[1][1] * zm1[1] + w[2][1] * z1;
        *(u32x4*)(ACONV + (size_t)(row0 + i) * LW + c0) = pack8(s0 * cv0, s1 * cv1);
        zm2[0] = zm1[0]; zm2[1] = zm1[1]; zm1[0] = z0; zm1[1] = z1;
    }
    if (t0 + 8 == T) {
        float* so = smp ? args.out + O_SSC + ((size_t)l * DBATCH + b) * 2 * LW + c0 : args.out + O_PSC + ((size_t)l * NBATCH + b) * 2 * LW + c0;
        *(f32x4*)so = zm2[0]; *(f32x4*)(so + 4) = zm2[1]; *(f32x4*)(so + LW) = zm1[0]; *(f32x4*)(so + LW + 4) = zm1[1];
        float* lo = smp ? args.out + O_SLC + ((size_t)l * DBATCH + b) * 3 * LW + c0 : args.out + O_PLC + ((size_t)l * NBATCH + b) * 3 * LW + c0;
#pragma unroll
        for (int k = 0; k < 3; ++k) { f32x4 x0, x1; unpack8(*(const u32x4*)(PROJ + (size_t)(row0 + 5 + k) * INC + C_LX + c0), x0, x1); *(f32x4*)(lo + k * LW) = x0; *(f32x4*)(lo + k * LW + 4) = x1; }
    }
}

__device__ __forceinline__ int crow(int r, int hi) { return (r & 3) + 8 * (r >> 2) + 4 * hi; }
constexpr int ATT_LDS = 8192;
__device__ __forceinline__ void attn_wg_unit(const Args& args, int l, int u, LAS unsigned char* lds, int tid_in) {
    int tid = tid_in; asm volatile("" : "+v"(tid));
    unsigned char* ws = args.ws;
    const bf16_t* PROJ = (const bf16_t*)(ws + WS_PROJ); bf16_t* AMEM = (bf16_t*)(ws + WS_ABR + 2 * SZ_ABR1);
    const int lane = tid & 63, wave = __builtin_amdgcn_readfirstlane(tid >> 6), r32 = lane & 31, hh = lane >> 5;
    const int panel = u >> 2, head = u & 3, b = panel >> 5, row0 = panel * 256 + 32 * wave;
    const bf16_t* Kb = (const bf16_t*)(ws + WS_KP) + (size_t)(l * NBATCH + b) * MEMLEN * MW + head * MHD;
    const bf16_t* Vt = (const bf16_t*)(ws + WS_VTP) + (size_t)((l * NBATCH + b) * MHEADS + head) * MHD * MEMLEN;
    LAS unsigned char* buf = lds + ATT_LDS;
    const int kkey = tid & 15, kdch = tid >> 4;
    const bf16_t* ksrc = Kb + (size_t)kkey * MW + 8 * kdch;
    const int kdst = (kdch >> 1) * 1024 + (kkey + 32 * (kdch & 1)) * 16;
    const int vd = tid >> 1, vs = tid & 1;
    const bf16_t* vsrc = Vt + (size_t)vd * MEMLEN + 16 * vs;
    const int vdst = ((vd >> 5) * 2 + vs) * 1024 + (vd & 31) * 16;
    bf16x8 qf[16];
    { const bf16_t* qp = PROJ + (size_t)(row0 + r32) * INC + C_Q + head * MHD + 8 * hh;
#pragma unroll
      for (int ks = 0; ks < 16; ++ks) qf[ks] = *(const bf16x8*)(qp + 16 * ks); }
    u32x4 s0, s1;
    s0 = *(const u32x4*)(ksrc); s1 = *(const u32x4*)(ksrc + (size_t)16 * MW);
    *(LAS u32x4*)(buf + kdst) = s0; *(LAS u32x4*)(buf + kdst + 256) = s1;
    __syncthreads();
    f32x16 st[8];
#pragma unroll
    for (int kt = 0; kt < 8; ++kt) {
        if (kt < 7) { s0 = *(const u32x4*)(ksrc + (size_t)(32 * (kt + 1)) * MW); s1 = *(const u32x4*)(ksrc + (size_t)(32 * (kt + 1) + 16) * MW); }
        else { s0 = *(const u32x4*)(vsrc); s1 = *(const u32x4*)(vsrc + 8); }
        const LAS unsigned char* cb = buf + (kt & 1) * 16384 + lane * 16;
        f32x16 acc;
#pragma unroll
        for (int i = 0; i < 16; ++i) acc[i] = 0.f;
#pragma unroll
        for (int ks = 0; ks < 16; ++ks) { const bf16x8 kf = *(const LAS bf16x8*)(cb + ks * 1024); acc = __builtin_amdgcn_mfma_f32_32x32x16_bf16(kf, qf[ks], acc, 0, 0, 0); }
        st[kt] = acc;
        LAS unsigned char* nb = buf + ((kt + 1) & 1) * 16384;
        if (kt < 7) { *(LAS u32x4*)(nb + kdst) = s0; *(LAS u32x4*)(nb + kdst + 256) = s1; }
        else { *(LAS u32x4*)(nb + vdst) = (u32x4){s0.x, s0.y, s1.x, s1.y}; *(LAS u32x4*)(nb + vdst + 512) = (u32x4){s0.z, s0.w, s1.z, s1.w}; }
        __syncthreads();
    }
    float mx = st[0][0];
#pragma unroll
    for (int kt = 0; kt < 8; ++kt)
#pragma unroll
        for (int i = 0; i < 16; ++i) mx = fmaxf(mx, st[kt][i]);
    mx = fmaxf(mx, __shfl_xor(mx, 32));
    float sum = 0.f;
    bf16x8 pf[8][2];
#pragma unroll
    for (int kt = 0; kt < 8; ++kt) {
#pragma unroll
        for (int i = 0; i < 16; ++i) { const float e = __builtin_amdgcn_exp2f(st[kt][i] - mx); st[kt][i] = e; sum += e; }
#pragma unroll
        for (int s = 0; s < 2; ++s) { u32x4 w; w.x = cvtpk(st[kt][8 * s + 0], st[kt][8 * s + 1]); w.y = cvtpk(st[kt][8 * s + 2], st[kt][8 * s + 3]); w.z = cvtpk(st[kt][8 * s + 4], st[kt][8 * s + 5]); w.w = cvtpk(st[kt][8 * s + 6], st[kt][8 * s + 7]);
            pf[kt][s] = __builtin_bit_cast(bf16x8, w); }
    }
    sum += __shfl_xor(sum, 32);
    const float inv = __builtin_amdgcn_rcpf(sum);
    f32x16 ot[8];
#pragma unroll
    for (int dt = 0; dt < 8; ++dt)
#pragma unroll
        for (int i = 0; i < 16; ++i) ot[dt][i] = 0.f;
#pragma unroll
    for (int kt = 0; kt < 8; ++kt) {
        if (kt < 7) { s0 = *(const u32x4*)(vsrc + 32 * (kt + 1)); s1 = *(const u32x4*)(vsrc + 32 * (kt + 1) + 8); }
        const LAS unsigned char* cb = buf + (kt & 1) * 16384 + lane * 16;
#pragma unroll
        for (int dt = 0; dt < 8; ++dt)
#pragma unroll
            for (int s = 0; s < 2; ++s) { const bf16x8 vf = *(const LAS bf16x8*)(cb + (dt * 2 + s) * 1024); ot[dt] = __builtin_amdgcn_mfma_f32_32x32x16_bf16(vf, pf[kt][s], ot[dt], 0, 0, 0); }
        if (kt < 7) {
            LAS unsigned char* nb = buf + ((kt + 1) & 1) * 16384;
            *(LAS u32x4*)(nb + vdst) = (u32x4){s0.x, s0.y, s1.x, s1.y}; *(LAS u32x4*)(nb + vdst + 512) = (u32x4){s0.z, s0.w, s1.z, s1.w};
        }
        __syncthreads();
    }
    bf16_t* op = AMEM + (size_t)(row0 + r32) * MW + head * MHD;
#pragma unroll
    for (int dt = 0; dt < 8; ++dt)
#pragma unroll
        for (int ig = 0; ig < 4; ++ig) {
            u32x2 w; w.x = cvtpk(ot[dt][4 * ig] * inv, ot[dt][4 * ig + 1] * inv); w.y = cvtpk(ot[dt][4 * ig + 2] * inv, ot[dt][4 * ig + 3] * inv);
            *(u32x2*)(op + 32 * dt + 8 * ig + 4 * hh) = w;
        }
}

__device__ __forceinline__ void attn_sample_unit(const Args& args, int l, int u, LAS unsigned char* lds, int tid_in) {
    int tid = tid_in; asm volatile("" : "+v"(tid));
    unsigned char* ws = args.ws;
    const bf16_t* PROJ = (const bf16_t*)(ws + WS_PROJ); bf16_t* AMEM = (bf16_t*)(ws + WS_ABR + 2 * SZ_ABR1);
    const int lane = tid & 63, wave = __builtin_amdgcn_readfirstlane(tid >> 6), r32 = lane & 31, hh = lane >> 5;
    const int head = u >> 5, b = u & 31, row0 = MP + b * DSEQ;
    const float* Kc = args.in[I_CK] + (size_t)(l * DBATCH + b) * MEMLEN * MW + head * MHD;
    const float* Vc = args.in[I_CV] + (size_t)(l * DBATCH + b) * MEMLEN * MW + head * MHD;
    LAS float* RMX = (LAS float*)(lds + ATT_LDS); LAS float* RSM = RMX + 256; LAS unsigned char* PB = lds + ATT_LDS + 4096;
    bf16x8 qf[16], kf[16];
    { const bf16_t* qp = PROJ + (size_t)(row0 + r32) * INC + C_Q + head * MHD + 8 * hh; const float* kp = Kc + (size_t)(32 * wave + r32) * MW + 8 * hh;
#pragma unroll
      for (int ks = 0; ks < 16; ++ks) { qf[ks] = *(const bf16x8*)(qp + 16 * ks); kf[ks] = __builtin_bit_cast(bf16x8, pack8(*(const f32x4*)(kp + 16 * ks), *(const f32x4*)(kp + 16 * ks + 4))); } }
    f32x16 acc;
#pragma unroll
    for (int i = 0; i < 16; ++i) acc[i] = 0.f;
#pragma unroll
    for (int ks = 0; ks < 16; ++ks) acc = __builtin_amdgcn_mfma_f32_32x32x16_bf16(kf[ks], qf[ks], acc, 0, 0, 0);
    float m = acc[0];
#pragma unroll
    for (int i = 1; i < 16; ++i) m = fmaxf(m, acc[i]);
    m = fmaxf(m, __shfl_xor(m, 32));
    if (hh == 0) RMX[wave * 32 + r32] = m;
    __syncthreads();
    float gm = RMX[r32];
#pragma unroll
    for (int w = 1; w < 8; ++w) gm = fmaxf(gm, RMX[w * 32 + r32]);
    float sm = 0.f;
#pragma unroll
    for (int i = 0; i < 16; ++i) { acc[i] = __builtin_amdgcn_exp2f(acc[i] - gm); sm += acc[i]; }
    sm += __shfl_xor(sm, 32);
    if (hh == 0) RSM[wave * 32 + r32] = sm;
#pragma unroll
    for (int s = 0; s < 2; ++s) { u32x4 w; w.x = cvtpk(acc[8 * s + 0], acc[8 * s + 1]); w.y = cvtpk(acc[8 * s + 2], acc[8 * s + 3]); w.z = cvtpk(acc[8 * s + 4], acc[8 * s + 5]); w.w = cvtpk(acc[8 * s + 6], acc[8 * s + 7]);
        *(LAS u32x4*)(PB + (wave * 2 + s) * 1024 + lane * 16) = w; }
    __syncthreads();
    float tot = 0.f;
#pragma unroll
    for (int w = 0; w < 8; ++w) tot += RSM[w * 32 + r32];
    const float inv = __builtin_amdgcn_rcpf(tot);
    f32x16 o;
#pragma unroll
    for (int i = 0; i < 16; ++i) o[i] = 0.f;
#pragma unroll
    for (int c = 0; c < 16; ++c) {
        const float* vp = Vc + (size_t)(16 * c + 4 * hh) * MW + 32 * wave + r32;
        u32x4 vw; vw.x = cvtpk(vp[0], vp[MW]); vw.y = cvtpk(vp[2 * MW], vp[3 * MW]); vw.z = cvtpk(vp[8 * MW], vp[9 * MW]); vw.w = cvtpk(vp[10 * MW], vp[11 * MW]);
        const bf16x8 vf = __builtin_bit_cast(bf16x8, vw);
        const bf16x8 pfr = *(const LAS bf16x8*)(PB + c * 1024 + lane * 16);
        o = __builtin_amdgcn_mfma_f32_32x32x16_bf16(vf, pfr, o, 0, 0, 0);
    }
    bf16_t* op = AMEM + (size_t)(row0 + r32) * MW + head * MHD + 32 * wave;
#pragma unroll
    for (int ig = 0; ig < 4; ++ig) {
        u32x2 w; w.x = cvtpk(o[4 * ig] * inv, o[4 * ig + 1] * inv); w.y = cvtpk(o[4 * ig + 2] * inv, o[4 * ig + 3] * inv);
        *(u32x2*)(op + 8 * ig + 4 * hh) = w;
    }
    __syncthreads();
}

template <int NR>
__device__ __forceinline__ void norm_prompt_rows(const Args& args, const float* gpost, bool last, bool want_q, const int (&rows)[NR], int lane) {
    unsigned char* ws = args.ws;
    const bf16_t* Y = (const bf16_t*)(ws + WS_Y); const float* SSY = (const float*)(ws + WS_SSY); bf16_t* XB = (bf16_t*)(ws + WS_XB); float* RS = (float*)(ws + WS_SSX);
    float part[NR], xs[NR], rstd[NR], ss[NR]; u32x4 xq[NR][4], yq[NR][4];
#pragma unroll
    for (int r = 0; r < NR; ++r) {
        part[r] = lane < 32 ? SSY[(size_t)rows[r] * 32 + lane] : 0.f; xs[r] = RS[rows[r]];
#pragma unroll
        for (int j = 0; j < 4; ++j) { xq[r][j] = __builtin_nontemporal_load((const u32x4*)(XB + (size_t)rows[r] * DM + j * 512 + lane * 8)); yq[r][j] = __builtin_nontemporal_load((const u32x4*)(Y + (size_t)rows[r] * DM + j * 512 + lane * 8)); }
    }
#pragma unroll
    for (int o = 1; o < 64; o <<= 1)
#pragma unroll
        for (int r = 0; r < NR; ++r) part[r] += __shfl_xor(part[r], o);
#pragma unroll
    for (int r = 0; r < NR; ++r) { rstd[r] = __builtin_amdgcn_rsqf(part[r] * (1.0f / DM) + EPS); ss[r] = 0.f; }
    f32x4 n0[NR][4], n1[NR][4];
#pragma unroll
    for (int j = 0; j < 4; ++j) {
        const int c = j * 512 + lane * 8;
        const f32x4 g0 = *(const f32x4*)(gpost + c), g1 = *(const f32x4*)(gpost + c + 4);
#pragma unroll
        for (int r = 0; r < NR; ++r) {
            f32x4 x0, x1, y0, y1; unpack8(xq[r][j], x0, x1); unpack8(yq[r][j], y0, y1);
            const f32x4 a = x0 * xs[r] + y0 * rstd[r] * g0, b = x1 * xs[r] + y1 * rstd[r] * g1;
            n0[r][j] = a; n1[r][j] = b;
            ss[r] += (a[0] * a[0] + a[1] * a[1]) + (a[2] * a[2] + a[3] * a[3]) + (b[0] * b[0] + b[1] * b[1]) + (b[2] * b[2] + b[3] * b[3]);
        }
    }
    if (last) {
#pragma unroll
        for (int r = 0; r < NR; ++r) { float* xo = args.out + (size_t)rows[r] * DM;
#pragma unroll
            for (int j = 0; j < 4; ++j) { *(f32x4*)(xo + j * 512 + lane * 8) = n0[r][j]; *(f32x4*)(xo + j * 512 + lane * 8 + 4) = n1[r][j]; } }
    } else {
#pragma unroll
        for (int o = 1; o < 64; o <<= 1)
#pragma unroll
            for (int r = 0; r < NR; ++r) ss[r] += __shfl_xor(ss[r], o);
#pragma unroll
        for (int r = 0; r < NR; ++r) {
            const float ms = ss[r] * (1.0f / DM) + EPS, rs2 = __builtin_amdgcn_rsqf(ms);
#pragma unroll
            for (int j = 0; j < 4; ++j) *(u32x4*)(XB + (size_t)rows[r] * DM + j * 512 + lane * 8) = pack8(n0[r][j] * rs2, n1[r][j] * rs2);
            if (lane == 0) RS[rows[r]] = __builtin_sqrtf(ms);
            if (want_q) row_quant8(n0[r], n1[r], rs2, ws + WS_XQ + (size_t)rows[r] * DM, (float*)(ws + WS_SA) + rows[r], lane);
        }
    }
}
__device__ __forceinline__ void norm_rows(const Args& args, const float* gpost, const float* yp, bool ybf, bool last, bool want_q, int gw, int ngw, int lane) {
    asm volatile("" : "+v"(lane)); asm volatile("" : "+s"(gw));
    unsigned char* ws = args.ws;
    bf16_t* XB = (bf16_t*)(ws + WS_XB); float* RS = (float*)(ws + WS_SSX);
    int row = gw;
    for (; row + ngw < MP; row += 2 * ngw) { const int rows[2] = {row, row + ngw}; norm_prompt_rows<2>(args, gpost, last, want_q, rows, lane); }
    for (; row < MP; row += ngw) { const int rows[1] = {row}; norm_prompt_rows<1>(args, gpost, last, want_q, rows, lane); }
    for (; row < MT; row += ngw) {
        f32x4 ya[4], yb[4];
        const float xs = RS[row];
        u32x4 xq[4];
#pragma unroll
        for (int j = 0; j < 4; ++j) xq[j] = *(const u32x4*)(XB + (size_t)row * DM + j * 512 + lane * 8);
        float sq = 0.f;
#pragma unroll
        for (int j = 0; j < 4; ++j) {
            f32x4 a, b;
            if (ybf) {
                const bf16_t* pp = (const bf16_t*)yp + (size_t)(row - MP) * DM + j * 512 + lane * 8;
                u32x4 pv[8];
#pragma unroll
                for (int s = 0; s < 8; ++s) pv[s] = *(const u32x4*)(pp + (size_t)s * MS * DM);
                unpack8(pv[0], a, b);
#pragma unroll
                for (int s = 1; s < 8; ++s) { f32x4 a2, b2; unpack8(pv[s], a2, b2); a += a2; b += b2; }
            } else {
                const float* pp = yp + (size_t)(row - MP) * DM + j * 512 + lane * 8;
                a = *(const f32x4*)pp; b = *(const f32x4*)(pp + 4);
#pragma unroll
                for (int s = 1; s < 8; ++s) { a += *(const f32x4*)(pp + (size_t)s * MS * DM); b += *(const f32x4*)(pp + (size_t)s * MS * DM + 4); }
            }
            ya[j] = a; yb[j] = b;
            sq += (a[0] * a[0] + a[1] * a[1]) + (a[2] * a[2] + a[3] * a[3]) + (b[0] * b[0] + b[1] * b[1]) + (b[2] * b[2] + b[3] * b[3]);
        }
        const float rstd = __builtin_amdgcn_rsqf(wave_sum(sq) * (1.0f / DM) + EPS);
        float ss = 0.f; f32x4 n0[4], n1[4];
#pragma unroll
        for (int j = 0; j < 4; ++j) {
            const int c = j * 512 + lane * 8;
            f32x4 x0, x1; unpack8(xq[j], x0, x1);
            const f32x4 g0 = *(const f32x4*)(gpost + c), g1 = *(const f32x4*)(gpost + c + 4);
            n0[j] = x0 * xs + ya[j] * rstd * g0; n1[j] = x1 * xs + yb[j] * rstd * g1;
            ss += (n0[j][0] * n0[j][0] + n0[j][1] * n0[j][1]) + (n0[j][2] * n0[j][2] + n0[j][3] * n0[j][3]) + (n1[j][0] * n1[j][0] + n1[j][1] * n1[j][1]) + (n1[j][2] * n1[j][2] + n1[j][3] * n1[j][3]);
        }
        if (last) {
            float* xo = args.out + (size_t)row * DM;
#pragma unroll
            for (int j = 0; j < 4; ++j) { *(f32x4*)(xo + j * 512 + lane * 8) = n0[j]; *(f32x4*)(xo + j * 512 + lane * 8 + 4) = n1[j]; }
        } else {
            const float ms = wave_sum(ss) * (1.0f / DM) + EPS, rs2 = __builtin_amdgcn_rsqf(ms);
#pragma unroll
            for (int j = 0; j < 4; ++j) *(u32x4*)(XB + (size_t)row * DM + j * 512 + lane * 8) = pack8(n0[j] * rs2, n1[j] * rs2);
            if (lane == 0) RS[row] = __builtin_sqrtf(ms);
            if (want_q) row_quant8(n0, n1, rs2, ws + WS_XQ + (size_t)row * DM, (float*)(ws + WS_SA) + row, lane);
        }
    }
}

__global__ void __launch_bounds__(512, 2) mk_fwd(Args args) {
    extern __shared__ __attribute__((aligned(16))) unsigned char lds_raw[];
    LAS unsigned char* lds = (LAS unsigned char*)lds_raw;
    volatile LAS unsigned* MISC = (volatile LAS unsigned*)(lds + MISC_OFF);
    const int tid = threadIdx.x, lane = tid & 63, wave = __builtin_amdgcn_readfirstlane(tid >> 6);
    const int G = gridDim.x, bx = blockIdx.x;
    const int vcu = (G % 8 == 0) ? (bx % 8) * (G / 8) + bx / 8 : bx;
    const int gw = vcu * 8 + wave, ngw = G * 8;
    unsigned char* ws = args.ws;
    if (tid < 64) MISC[tid] = 0u;
    __syncthreads();
    XcdBarrier bar; bar.bar = (unsigned*)(ws + WS_CTL) + 4096; bar.x = 0; bar.st = MISC + 8;
    if (!MK_MULTI) bar = xcd_barrier_post((unsigned*)(ws + WS_CTL) + 4096, MISC + 8);
    const int lo = args.ph_lo, hi = args.ph_hi;
#define IN(k) (lo <= (k) && (k) < hi)
#define SEAM(k) do { if (IN(k) && IN((k) + 1)) for (int rr = 0; rr < DUP_BAR; ++rr) xcd_barrier(bar); } while (0)

    if (IN(0)) for (int rr = 0; rr < DUP_PRO; ++rr) {
        LAS float* scr = (LAS float*)(lds + wave * 16384);
        for (int t = gw; t < DEPTH * 60 * 16; t += ngw) {
            const int lr = t / (60 * 16), l = DEPTH - 1 - lr, r_ = t - lr * (60 * 16), strip = r_ >> 4, kb = r_ & 15;
            const bool up = strip >= 28; const int c0 = (up ? strip - 28 : strip) * 256 + 4 * lane, pitch = up ? DFF : INC;
            const float* wp = (up ? args.in[I_WUP] + (size_t)l * DM * DFF : args.in[I_WIN] + (size_t)l * DM * INC + C_I8) + (size_t)(kb * 128) * pitch + c0;
            const float* gp = (up ? args.in[I_GMLPPRE] : args.in[I_GMIXPRE]) + l * DM + kb * 128;
            f32x4 m = (f32x4){0.f, 0.f, 0.f, 0.f};
#pragma unroll 16
            for (int k = 0; k < 128; ++k) { const f32x4 v = *(const f32x4*)(wp + (size_t)k * pitch); const float g_ = __builtin_fabsf(gp[k]);
                m[0] = fmaxf(m[0], __builtin_fabsf(v[0]) * g_); m[1] = fmaxf(m[1], __builtin_fabsf(v[1]) * g_); m[2] = fmaxf(m[2], __builtin_fabsf(v[2]) * g_); m[3] = fmaxf(m[3], __builtin_fabsf(v[3]) * g_); }
            unsigned* cm = (unsigned*)(ws + WS_CTL) + CW_CMAX + l * CM_L + (up ? NI8 : 0) + c0;
#pragma unroll
            for (int e = 0; e < 4; ++e) atomicMax(cm + e, __float_as_uint(m[e]));
        }
        for (int t = gw; t < DEPTH * 8 * 64; t += ngw) {
            const int l = DEPTH - 1 - (t >> 9), r_ = t & 511, strip = r_ >> 6, kb = r_ & 63, c0 = strip * 256 + 4 * lane;
            const float* wp = args.in[I_WDN] + (size_t)l * DFF * DM + (size_t)(kb * 128) * DM + c0;
            f32x4 m = (f32x4){0.f, 0.f, 0.f, 0.f};
#pragma unroll 16
            for (int k = 0; k < 128; ++k) { const f32x4 v = *(const f32x4*)(wp + (size_t)k * DM);
                m[0] = fmaxf(m[0], __builtin_fabsf(v[0])); m[1] = fmaxf(m[1], __builtin_fabsf(v[1])); m[2] = fmaxf(m[2], __builtin_fabsf(v[2])); m[3] = fmaxf(m[3], __builtin_fabsf(v[3])); }
            unsigned* cm = (unsigned*)(ws + WS_CTL) + CW_CMAX + l * CM_L + NI8 + DFF + c0;
#pragma unroll
            for (int e = 0; e < 4; ++e) atomicMax(cm + e, __float_as_uint(m[e]));
        }
        if (!MK_MULTI) xcd_barrier(bar);
        conv_stream<true>(args, scr, lane, 0, IT_LW + (IT_ALL - IT_W), gw, ngw, IT_LW, IT_W - IT_LW);
        { float* c8t = (float*)(ws + WS_PA); const float* lam = args.in[I_LAM];
          for (int i = gw * 64 + lane; i < DEPTH * LW; i += ngw * 64) c8t[i] = 8.0f * log1pf(__expf(-lam[i])); }
        { bf16_t* wat = (bf16_t*)(ws + WS_WAT); bf16_t* wit = (bf16_t*)(ws + WS_WIT); const float* wa = args.in[I_LWA]; const float* wi = args.in[I_LWI];
          for (int i = gw * 64 + lane; i < DEPTH * LHEADS * 64 * 64; i += ngw * 64) { const int hh = i >> 12, jj = (i >> 6) & 63, ii = i & 63; wat[i] = f2bf(wa[(hh * 64 + ii) * 64 + jj]); wit[i] = f2bf(wi[(hh * 64 + ii) * 64 + jj]); } }
        { bf16_t* sl = (bf16_t*)(ws + WS_SLCB); const float* s = args.in[I_SLC]; const int n8 = DEPTH * DBATCH * 3 * LW / 8;
          for (int i = gw * 64 + lane; i < n8; i += ngw * 64) { const f32x4 a = *(const f32x4*)(s + (size_t)i * 8), b = *(const f32x4*)(s + (size_t)i * 8 + 4); *(u32x4*)(sl + (size_t)i * 8) = pack8(a, b); } }
        { bf16_t* XB = (bf16_t*)(ws + WS_XB);
          for (int row = gw; row < MT; row += ngw) { const float* xr = row < MP ? args.in[I_XP] + (size_t)row * DM : args.in[I_XS] + (size_t)(row - MP) * DM; const float sc = row_to_bf16_normed(xr, XB + (size_t)row * DM, lane, ws + WS_XQ + (size_t)row * DM, (float*)(ws + WS_SA) + row); if (lane == 0) ((float*)(ws + WS_SSX))[row] = sc; } }
        { bf16_t* MB = (bf16_t*)(ws + WS_MEMB);
          for (int row = gw; row < NBATCH * MEMLEN; row += ngw) row_to_bf16_normed(args.in[I_MEM] + (size_t)row * DM, MB + (size_t)row * DM, lane); }
        __syncthreads();
    }
    SEAM(0);

    for (int l = 0; l < DEPTH; ++l) {
        const int pb = 1 + 9 * l;
        if (IN(pb + 0)) {
#ifndef NO_KV
            if (l == 0) {
                pg8::Gemm g{(const char*)(ws + WS_MEMB), (const char*)(ws + WS_WKV), DM, DM, DM, 0, 0};
                pg8::KvOrder S{bx};
                pg8::EpiKV E{args.out + O_PMK, args.out + O_PMV, (bf16_t*)(ws + WS_KP), (bf16_t*)(ws + WS_VTP)};
                pg8::gemm_phase<pg8::EpiKV, pg8::KvOrder>(lds, g, S, E);
            }
#endif

#ifndef NO_GIN
            {
                pg8::Gemm g{(const char*)(ws + WS_XB), (const char*)(ws + WS_WIN + l * SZ_WIN), DM, DM, DM, 0, 0};
                pg8::StaticOrder S; S.init(MT, C_I8, G, bx); S.ntk = DM / 64;
                pg8::EpiIn E{(bf16_t*)(ws + WS_PROJ), args.in[I_BGATE] + (size_t)l * 3 * DM};
                for (int rr = 0; rr < DUP_GIN; ++rr) pg8::gemm_phase<pg8::EpiIn, pg8::StaticOrder>(lds, g, S, E);
            }
            {
                pg8::Gemm g{(const char*)(ws + WS_XQ), (const char*)(ws + WS_WIN + l * SZ_WIN + WQ_OFF), DM / 2, DM / 2, DM / 2, 0, 0};
                pg8::StaticOrder S; S.init(MT, NI8, G, G - 1 - bx); S.ntk = DM / 128;
                pg8::EpiIn8 E{(bf16_t*)(ws + WS_PROJ), args.in[I_BGATE] + (size_t)l * 3 * DM, (const float*)(ws + WS_SA), (const unsigned*)(ws + WS_CTL) + CW_CMAX + l * CM_L, ws + WS_G8};
                pg8::gemm_phase<pg8::EpiIn8, pg8::StaticOrder, true>(lds, g, S, E);
            }
#endif
        }
        SEAM(pb + 0);
        if (IN(pb + 2)) for (int rep = 0; rep < DUP_THIN; ++rep) {
            if (rep) __syncthreads();
#ifndef NO_LRUF
            for (int rr = 0; rr < DUP_LRU; ++rr)
            for (int u = vcu; u < 64 * LHEADS; u += G) lru_unit<true, false>(args, l, u >> 4, u & 15, lds, wave, lane);
            for (int u = 64 * LHEADS + vcu; u < NPANEL * LHEADS; u += G) lru_unit<true, true>(args, l, u >> 4, u & 15, lds, wave, lane);
#endif
#ifndef NO_ATTN
            for (int u = vcu; u < 256; u += G) attn_wg_unit(args, l, u, lds, tid);
            if (G == 256) {
                if (vcu >= 128) attn_sample_unit(args, l, vcu - 128, lds, tid);
#ifndef NO_SCONV
                if (vcu >= 64) for (int it = (vcu - 64) * 8 + wave; it < (MT / 8) * 2; it += 192 * 8) sconv_item(args, l, it, lane);
#endif
            } else {
                for (int u = vcu; u < 128; u += G) attn_sample_unit(args, l, u, lds, tid);
#ifndef NO_SCONV
                for (int it = gw; it < (MT / 8) * 2; it += ngw) sconv_item(args, l, it, lane);
#endif
            }
#endif
        }
        SEAM(pb + 2);
        if (IN(pb + 3)) {
#ifndef NO_GBR
            pg8::Gemm g{(const char*)(ws + WS_ABR), (const char*)(ws + WS_WBR + (size_t)l * 3 * SZ_WBR1), 1024, 1024, 1024, SZ_ABR1, SZ_WBR1};
            pg8::Seg3Order S; S.init(MP, DM, G, bx); S.ntk = 1024 / 64;
            pg8::EpiBranch E{(const unsigned char*)(ws + WS_G8), (bf16_t*)(ws + WS_MERGED)};
            for (int rr = 0; rr < DUP_GBR; ++rr) pg8::gemm_phase<pg8::EpiBranch, pg8::Seg3Order>(lds, g, S, E);
            pg8::SegSubOrder S2{bx}; pg8::EpiPart E2{(float*)(ws + WS_BP)};
            pg8::gemm_phase<pg8::EpiPart, pg8::SegSubOrder>(lds, g, S2, E2);
            if (l + 1 < DEPTH && G == 256 && bx >= 96)
                conv_stream<false>(args, (LAS float*)(lds + wave * 16384), lane, (l + 1) * IT_LW, (l + 1) * IT_LW + CV_B, (bx - 96) * 8 + wave, 160 * 8);
#endif

        }
        SEAM(pb + 3);
        if (IN(pb + 4)) {
            {
                const float* bp = (const float*)(ws + WS_BP); const bf16_t* PROJ = (const bf16_t*)(ws + WS_PROJ); bf16_t* Mg = (bf16_t*)(ws + WS_MERGED);
                int ln = lane; asm volatile("" : "+v"(ln));
                for (int i = gw * 64 + ln; i < MS * DM / 8; i += ngw * 64) {
                    const int r = i >> 8, c = (i & 255) * 8;
                    f32x4 o0 = (f32x4){0.f, 0.f, 0.f, 0.f}, o1 = o0;
#pragma unroll
                    for (int s = 0; s < 3; ++s) {
                        const float* pp = bp + ((size_t)s * MS + r) * DM + c; f32x4 g0, g1; pg8::unpack8u(*(const u32x2*)(ws + WS_G8 + pg8::g8_tile(64 + (r >> 8), s * 8 + (c >> 8)) + ((((r >> 6) & 1) * 4 + ((c >> 6) & 3)) * 16 + (((r >> 7) & 1) * 4 + ((r >> 4) & 3)) * 2 + ((c >> 5) & 1)) * 512 + (((c >> 3) & 3) * 16 + (r & 15)) * 8), g0, g1); g0 = g0 * (1.0f / 255.0f); g1 = g1 * (1.0f / 255.0f);
                        o0 += g0 * *(const f32x4*)pp; o1 += g1 * *(const f32x4*)(pp + 4);
                    }
                    *(u32x4*)(Mg + (size_t)(MP + r) * DM + c) = pack8(o0, o1);
                }
                if (!MK_MULTI) xcd_barrier(bar);
            }
#ifndef NO_GOUT
            pg8::Gemm g{(const char*)(ws + WS_MERGED), (const char*)(ws + WS_WOUT + l * SZ_WOUT), DM, DM, DM, 0, 0};
            pg8::SplitOrder S; S.init(MP, DM, G, bx); S.ntk = DM / 64;
            pg8::EpiY E{(bf16_t*)(ws + WS_Y), (float*)(ws + WS_SSY), (float*)(ws + WS_PROJ)};
            for (int rr = 0; rr < DUP_GOUT; ++rr) pg8::gemm_phase<pg8::EpiY, pg8::SplitOrder>(lds, g, S, E);
#endif

        }
        SEAM(pb + 4);
        if (IN(pb + 5)) norm_rows(args, args.in[I_GMIXPOST] + (size_t)l * DM, (const float*)(ws + WS_PROJ), true, false, true, gw, ngw, lane);
        SEAM(pb + 5);
        if (IN(pb + 6)) {
#ifndef NO_GUP
            pg8::Gemm g{(const char*)(ws + WS_XQ), (const char*)(ws + WS_WUP + l * SZ_WUP), DM / 2, DM / 2, DM / 2, 0, 0};
            pg8::UpOrder S{bx, G, DM / 128};
            for (int rr = 0; rr < DUP_GUP; ++rr) {
            pg8::EpiUp8 E{ws, l, l * DUP_GUP + rr + 1};
            pg8::gemm_phase<pg8::EpiUp8, pg8::UpOrder, true>(lds, g, S, E); }
            if (l + 1 < DEPTH && G == 256 && bx >= 128)
                conv_stream<false>(args, (LAS float*)(lds + wave * 16384), lane, (l + 1) * IT_LW + CV_B, (l + 2) * IT_LW, (bx - 128) * 8 + wave, 128 * 8);
#endif

        }
        SEAM(pb + 6);
        if (IN(pb + 7)) {
#ifndef NO_GDN
            pg8::Gemm g{(const char*)(ws + WS_PROJ), (const char*)(ws + WS_WDN + l * SZ_WUP), DFF / 2, DFF / 2, DFF / 2, 0, 0};
            pg8::SplitOrder S; S.init(MP, DM, G, bx); S.ntk = DFF / 128;
            pg8::EpiY8 E{(bf16_t*)(ws + WS_Y), (float*)(ws + WS_SSY), (float*)(ws + WS_MERGED), (const unsigned*)(ws + WS_CTL) + CW_RMAX + l * MT,
                         (const unsigned*)(ws + WS_CTL) + CW_CMAX + l * CM_L + NI8 + DFF, (const int*)(ws + WS_CTL) + cw_csum9(l)};
            for (int rr = 0; rr < DUP_GDN; ++rr) pg8::gemm_phase<pg8::EpiY8, pg8::SplitOrder, true>(lds, g, S, E);
#endif

        }
        SEAM(pb + 7);
        if (IN(pb + 8)) norm_rows(args, args.in[I_GMLPPOST] + (size_t)l * DM, (const float*)(ws + WS_MERGED), true, l == DEPTH - 1, true, gw, ngw, lane);
        SEAM(pb + 8);
    }
#undef IN
#undef SEAM
}

extern "C" void kernel_launch(void* const* d_in, const int* in_sizes, int n_in, void* d_out, int out_size, void* d_ws, size_t ws_size, hipStream_t stream) {
    static int grid = 0;
    if (grid == 0) {
        if (n_in != 30 || out_size != (int)O_END || ws_size < WS_END) { fprintf(stderr, "kernel_launch: unexpected shapes (n_in %d, out %d, ws %zu < %zu)\n", n_in, out_size, ws_size, (size_t)WS_END); grid = -1; return; }
        int dev = 0, cus = 0, per_cu = 0;
        if (hipGetDevice(&dev) != hipSuccess || hipDeviceGetAttribute(&cus, hipDeviceAttributeMultiprocessorCount, dev) != hipSuccess) { grid = -1; return; }
        if (hipFuncSetAttribute((const void*)mk_fwd, hipFuncAttributeMaxDynamicSharedMemorySize, LDS_BYTES) != hipSuccess) { fprintf(stderr, "kernel_launch: hipFuncSetAttribute failed\n"); grid = -1; return; }
        if (hipOccupancyMaxActiveBlocksPerMultiprocessor(&per_cu, (const void*)mk_fwd, 512, LDS_BYTES) != hipSuccess || per_cu < 1) fprintf(stderr, "kernel_launch: occupancy query reports %d\n", per_cu);
        (void)hipGetLastError();
        grid = cus;
    }
    if (grid < 0) return;
    static_assert(WS_GRAN == 0 && WS_CTL == 1 * MiB, "the two zeroed regions are adjacent");
    if (hipMemsetAsync((char*)d_ws + WS_GRAN, 0, 1 * MiB + CTL_ZERO_BYTES, stream) != hipSuccess) return;
    Args a{};
    for (int i = 0; i < 30; ++i) a.in[i] = (const float*)d_in[i];
    a.out = (float*)d_out; a.ws = (unsigned char*)d_ws;
#if MK_MULTI
    for (int p = 0; p < NPH; ++p) { a.ph_lo = p; a.ph_hi = p + 1; hipLaunchKernelGGL(mk_fwd, dim3(grid), dim3(512), LDS_BYTES, stream, a); }
#else
    a.ph_lo = 0; a.ph_hi = NPH;
    hipLaunchKernelGGL(mk_fwd, dim3(grid), dim3(512), LDS_BYTES, stream, a);
#endif
}
```
